# Optimizing an MI355X kernel written in HIP

```python
import math
import jax, jax.numpy as jnp
from jax import lax
import numpy as np

D_MODEL = 2048
BATCH = 4
SEQ = 4096
DEPTH = 2

GRID_W = 64
HEAD_DIM = 64
ROPE_THETA = 10000.0
NORM_EPS = 1e-6
NEG_INF = -1e30

SSM_HEADS = 8
SSM_HEAD_DIM = 64
SSM_INNER = SSM_HEADS * SSM_HEAD_DIM
SSM_GROUPS = 2
SSM_STATE = 128
SSM_CONV = 5
SSM_CHUNK = 128
SSM_CONV_CH = SSM_INNER + 2 * SSM_GROUPS * SSM_STATE

NA_HEADS = 8
NA_WIN_ROWS = 8
NA_WIN_COLS = 16
NA_COL_BLOCK = 16
NA_KEY_COLS = 32

MLA_HEADS = 8
MLA_Q_RANK = 512
MLA_KV_RANK = 512
MLA_NOPE = 64
MLA_ROPE = 32
MLA_V = 64
MLA_QBLOCK = 128

DIL_HEADS = 8
DIL_PAIRS = ((128, 1), (512, 4), (2048, 16))
DIL_QBLOCK = 128

D_MIX = SSM_INNER + NA_HEADS * HEAD_DIM + MLA_HEADS * MLA_V + DIL_HEADS * HEAD_DIM
IN_SIZES = (SSM_INNER, SSM_CONV_CH, 2 * SSM_HEADS,
            NA_HEADS * HEAD_DIM, NA_HEADS * HEAD_DIM, NA_HEADS * HEAD_DIM,
            MLA_Q_RANK, MLA_KV_RANK, MLA_ROPE,
            DIL_HEADS * HEAD_DIM, DIL_HEADS * HEAD_DIM, DIL_HEADS * HEAD_DIM)
D_IN = sum(IN_SIZES)

D_FF = 5632
N_EXPERTS = 8
TOP_K = 2
D_FF_EXPERT = 5632
N_DENSE = (DEPTH + 1) // 2
N_MOE = DEPTH // 2

kernel_name = 'hybrid_parallel_heads_encoder'


def rms_norm(x, w):
    xf = x.astype(jnp.float32)
    y = xf * lax.rsqrt(jnp.mean(xf * xf, axis=-1, keepdims=True) + NORM_EPS)
    return (y * w.astype(jnp.float32)).astype(x.dtype)


def rope(x, pos):
    d = x.shape[-1]
    inv = ROPE_THETA ** (-jnp.arange(0, d, 2, dtype=jnp.float32) / d)
    ang = pos[:, None] * inv[None, :]
    cos = jnp.cos(ang)[:, None, :]
    sin = jnp.sin(ang)[:, None, :]
    xf = x.astype(jnp.float32)
    x1, x2 = xf[..., : d // 2], xf[..., d // 2:]
    return jnp.concatenate([x1 * cos - x2 * sin, x2 * cos + x1 * sin], axis=-1).astype(x.dtype)


def split_heads(a, n_heads):
    b, t, _ = a.shape
    return a.reshape(b, t, n_heads, -1)


def ssd_chunked(x, dt, a, bmat, cmat):
    b, t, h, p = x.shape
    n = bmat.shape[-1]
    q = SSM_CHUNK
    nc = t // q
    xs = (x.astype(jnp.float32) * dt[..., None]).reshape(b, nc, q, h, p)
    bc = bmat.astype(jnp.float32).reshape(b, nc, q, h, n)
    cc = cmat.astype(jnp.float32).reshape(b, nc, q, h, n)
    da = (dt * a).reshape(b, nc, q, h).transpose(0, 3, 1, 2)
    cs = jnp.cumsum(da, axis=-1)
    lower = np.tril(np.ones((q, q), dtype=bool))
    decay = jnp.exp(jnp.where(lower, cs[..., :, None] - cs[..., None, :], -jnp.inf))
    scores = jnp.einsum('bclhn,bcshn->bhcls', cc, bc) * decay
    y_diag = jnp.einsum('bhcls,bcshp->bclhp', scores, xs)
    decay_to_end = jnp.exp(cs[..., -1:] - cs)
    chunk_states = jnp.einsum('bclhn,bhcl,bclhp->cbhpn', bc, decay_to_end, xs)
    chunk_decay = jnp.exp(cs[..., -1]).transpose(2, 0, 1)

    def carry_state(state, inp):
        s_c, d_c = inp
        return state * d_c[..., None, None] + s_c, state

    _, prev = lax.scan(carry_state, jnp.zeros((b, h, p, n), jnp.float32), (chunk_states, chunk_decay))
    y_off = jnp.einsum('bclhn,cbhpn,bhcl->bclhp', cc, prev, jnp.exp(cs))
    return (y_diag + y_off).reshape(b, t, h, p)


def mamba2_bidirectional(z, xbc, dt_raw, conv_w, conv_b, a_log, dt_bias, d_skip, norm_w):
    b, t, _ = xbc.shape
    pad = SSM_CONV // 2
    xbc = lax.conv_general_dilated(xbc, conv_w.reshape(SSM_CONV, 1, SSM_CONV_CH), (1,), [(pad, pad)],
                                   dimension_numbers=('NWC', 'WIO', 'NWC'),
                                   feature_group_count=SSM_CONV_CH)
    xbc = jax.nn.silu(xbc + conv_b)
    xs, bm, cm = jnp.split(xbc, [SSM_INNER, SSM_INNER + SSM_GROUPS * SSM_STATE], axis=-1)
    xs = xs.reshape(b, t, SSM_HEADS, SSM_HEAD_DIM)
    rep = SSM_HEADS // SSM_GROUPS
    bm = jnp.repeat(bm.reshape(b, t, SSM_GROUPS, SSM_STATE), rep, axis=2)
    cm = jnp.repeat(cm.reshape(b, t, SSM_GROUPS, SSM_STATE), rep, axis=2)
    dt = jax.nn.softplus(dt_raw.astype(jnp.float32) + dt_bias.astype(jnp.float32).reshape(-1))
    dt = dt.reshape(b, t, 2, SSM_HEADS)
    a = -jnp.exp(a_log.astype(jnp.float32))
    flip = lambda u: jnp.flip(u, axis=1)
    y_fwd = ssd_chunked(xs, dt[:, :, 0], a[0], bm, cm)
    y_bwd = flip(ssd_chunked(flip(xs), flip(dt[:, :, 1]), a[1], flip(bm), flip(cm)))
    y = y_fwd + y_bwd + xs.astype(jnp.float32) * d_skip.astype(jnp.float32)[:, None]
    y = y.reshape(b, t, SSM_INNER).astype(z.dtype)
    return rms_norm(y * jax.nn.silu(z), norm_w)


def neighborhood_attention(q, k, v, rpb):
    b, t, h, d = q.shape
    rows = t // GRID_W
    kr = min(NA_WIN_ROWS, rows)
    ncb = GRID_W // NA_COL_BLOCK
    r_idx = np.arange(rows)
    row_start = np.clip(r_idx - kr // 2, 0, rows - kr)
    key_rows = row_start[:, None] + np.arange(kr)[None, :]
    cb = np.arange(ncb)
    blk_col_start = np.clip(cb * NA_COL_BLOCK - NA_WIN_COLS // 2, 0, GRID_W - NA_KEY_COLS)
    key_cols = blk_col_start[:, None] + np.arange(NA_KEY_COLS)[None, :]
    q_cols = cb[:, None] * NA_COL_BLOCK + np.arange(NA_COL_BLOCK)[None, :]
    q_col_start = np.clip(q_cols - NA_WIN_COLS // 2, 0, GRID_W - NA_WIN_COLS)
    kc = key_cols[:, None, :]
    col_in = (kc >= q_col_start[..., None]) & (kc < q_col_start[..., None] + NA_WIN_COLS)
    row_off = key_rows - r_idx[:, None] + NA_WIN_ROWS - 1
    col_off = np.clip(kc - q_cols[..., None] + NA_WIN_COLS - 1, 0, 2 * NA_WIN_COLS - 2)
    bias = rpb[:, row_off[:, None, None, :, None], col_off[None, :, :, None, :]]

    qg = q.reshape(b, rows, ncb, NA_COL_BLOCK, h, d)
    kg = k.reshape(b, rows, GRID_W, h, d)
    vg = v.reshape(b, rows, GRID_W, h, d)
    ridx = key_rows[:, None, :, None]
    cidx = key_cols[None, :, None, :]
    kb = kg[:, ridx, cidx]
    vb = vg[:, ridx, cidx]
    s = jnp.einsum('brcqhd,brckjhd->bhrcqkj', qg, kb).astype(jnp.float32) * (d ** -0.5)
    s = s + bias[None].astype(jnp.float32)
    s = jnp.where(col_in[:, :, None, :], s, NEG_INF)
    s = s.reshape(b, h, rows, ncb, NA_COL_BLOCK, kr * NA_KEY_COLS)
    p = jax.nn.softmax(s, axis=-1).astype(v.dtype)
    vb = vb.reshape(b, rows, ncb, kr * NA_KEY_COLS, h, d)
    o = jnp.einsum('bhrcqn,brcnhd->brcqhd', p, vb)
    return o.reshape(b, t, h, d)


def global_attention(q, k, v):
    b, t, h, dk = q.shape
    nb = t // MLA_QBLOCK
    scale = dk ** -0.5
    qb = q.reshape(b, nb, MLA_QBLOCK, h, dk).transpose(1, 0, 2, 3, 4)

    def block(qi):
        s = jnp.einsum('bqhd,bkhd->bhqk', qi, k).astype(jnp.float32) * scale
        p = jax.nn.softmax(s, axis=-1).astype(v.dtype)
        return jnp.einsum('bhqk,bkhd->bqhd', p, v)

    o = lax.map(block, qb)
    return o.transpose(1, 0, 2, 3, 4).reshape(b, t, h, -1)


def mla_mixer(c_q, c_kv, k_rope, q_norm_w, kv_norm_w, w_uq, w_ukv, pos):
    b, t, _ = c_q.shape
    q = (rms_norm(c_q, q_norm_w) @ w_uq).reshape(b, t, MLA_HEADS, MLA_NOPE + MLA_ROPE)
    kv = (rms_norm(c_kv, kv_norm_w) @ w_ukv).reshape(b, t, MLA_HEADS, MLA_NOPE + MLA_V)
    q_nope, q_pe = q[..., :MLA_NOPE], q[..., MLA_NOPE:]
    k_nope, v = kv[..., :MLA_NOPE], kv[..., MLA_NOPE:]
    q_pe = rope(q_pe, pos)
    k_pe = rope(k_rope[:, :, None, :], pos)
    k_pe = jnp.broadcast_to(k_pe, (b, t, MLA_HEADS, MLA_ROPE))
    qf = jnp.concatenate([q_nope, q_pe], axis=-1)
    kf = jnp.concatenate([k_nope, k_pe], axis=-1)
    return global_attention(qf, kf, v)


def banded_attention(q, k, v, half):
    n, length, h, d = q.shape
    qbs = math.gcd(length, DIL_QBLOCK)
    nb = length // qbs
    span = qbs + 2 * half
    kp = jnp.pad(k, ((0, 0), (half, half), (0, 0), (0, 0)))
    vp = jnp.pad(v, ((0, 0), (half, half), (0, 0), (0, 0)))
    idx = np.arange(nb)[:, None] * qbs + np.arange(span)[None, :]
    kb = kp[:, idx]
    vb = vp[:, idx]
    qb = q.reshape(n, nb, qbs, h, d)
    s = jnp.einsum('nbqhd,nbkhd->nhbqk', qb, kb).astype(jnp.float32) * (d ** -0.5)
    key_pos = (idx - half)[:, None, :]
    q_pos = (np.arange(nb)[:, None] * qbs + np.arange(qbs)[None, :])[:, :, None]
    valid = (np.abs(key_pos - q_pos) <= half) & (key_pos >= 0) & (key_pos < length)
    s = jnp.where(valid, s, NEG_INF)
    m = jnp.max(s, axis=-1, keepdims=True)
    p = jnp.exp(s - m)
    l = jnp.sum(p, axis=-1, keepdims=True)
    o = jnp.einsum('nhbqk,nbkhd->nbqhd', p, vb.astype(jnp.float32))
    o = o / l.transpose(0, 2, 3, 1, 4)
    lse = (m + jnp.log(l))[..., 0].transpose(0, 2, 3, 1)
    return o.reshape(n, length, h, d), lse.reshape(n, length, h)


def dilated_mixer(q, k, v):
    b, t, h, d = q.shape
    outs, lses = [], []
    for window, dil in DIL_PAIRS:
        half = window // (2 * dil)
        sub = t // dil
        fold = lambda a: a.reshape(b, sub, dil, h, d).transpose(0, 2, 1, 3, 4).reshape(b * dil, sub, h, d)
        o, lse = banded_attention(fold(q), fold(k), fold(v), half)
        outs.append(o.reshape(b, dil, sub, h, d).transpose(0, 2, 1, 3, 4).reshape(b, t, h, d))
        lses.append(lse.reshape(b, dil, sub, h).transpose(0, 2, 1, 3).reshape(b, t, h))
    w = jax.nn.softmax(jnp.stack(lses, axis=0), axis=0)
    out = jnp.sum(w[..., None] * jnp.stack(outs, axis=0), axis=0)
    return out.astype(q.dtype)


def swiglu(h, w_gate, w_up, w_down):
    return (jax.nn.silu(h @ w_gate) * (h @ w_up)) @ w_down


def moe_swiglu(h, router_w, w_gate, w_up, w_down):
    logits = (h @ router_w).astype(jnp.float32)
    top_v, top_i = lax.top_k(logits, TOP_K)
    gates = jax.nn.softmax(top_v, axis=-1)
    dense_gate = jnp.sum(jax.nn.one_hot(top_i, N_EXPERTS, dtype=jnp.float32) * gates[..., None], axis=-2)
    dense_gate = dense_gate.astype(h.dtype)
    out = jnp.zeros_like(h)
    for e in range(N_EXPERTS):
        out = out + dense_gate[..., e:e + 1] * swiglu(h, w_gate[e], w_up[e], w_down[e])
    return out


def setup_inputs(seed: int = 0) -> dict:
    key = jax.random.key(seed)
    ks = jax.random.split(key, 32)
    f32 = jnp.float32
    nrm = lambda i, shape, fan_in: jax.random.normal(ks[i], shape, f32) * (fan_in ** -0.5)
    gain = lambda i, shape: 1.0 + 0.05 * jax.random.normal(ks[i], shape, f32)
    x = jax.random.normal(ks[0], (BATCH, SEQ, D_MODEL), f32)
    attn_norm_w = gain(1, (DEPTH, D_MODEL))
    w_in = nrm(2, (DEPTH, D_MODEL, D_IN), D_MODEL)
    conv_w = nrm(3, (DEPTH, SSM_CONV, SSM_CONV_CH), SSM_CONV)
    conv_b = 0.02 * jax.random.normal(ks[4], (DEPTH, SSM_CONV_CH), f32)
    a_log = jnp.log(jax.random.uniform(ks[5], (DEPTH, 2, SSM_HEADS), f32, 1.0, 16.0))
    dt0 = jnp.exp(jax.random.uniform(ks[6], (DEPTH, 2, SSM_HEADS), f32, math.log(1e-3), math.log(1e-1)))
    dt_bias = dt0 + jnp.log(-jnp.expm1(-dt0))
    d_skip = gain(7, (DEPTH, SSM_HEADS))
    ssm_norm_w = gain(8, (DEPTH, SSM_INNER))
    na_rpb = 0.1 * jax.random.normal(ks[9], (DEPTH, NA_HEADS, 2 * NA_WIN_ROWS - 1, 2 * NA_WIN_COLS - 1), f32)
    mla_q_norm_w = gain(10, (DEPTH, MLA_Q_RANK))
    mla_kv_norm_w = gain(11, (DEPTH, MLA_KV_RANK))
    mla_w_uq = nrm(12, (DEPTH, MLA_Q_RANK, MLA_HEADS * (MLA_NOPE + MLA_ROPE)), MLA_Q_RANK)
    mla_w_ukv = nrm(13, (DEPTH, MLA_KV_RANK, MLA_HEADS * (MLA_NOPE + MLA_V)), MLA_KV_RANK)
    w_o = nrm(14, (DEPTH, D_MIX, D_MODEL), D_MIX)
    ffn_norm_w = gain(15, (DEPTH, D_MODEL))
    ffn_w_gate = nrm(16, (N_DENSE, D_MODEL, D_FF), D_MODEL)
    ffn_w_up = nrm(17, (N_DENSE, D_MODEL, D_FF), D_MODEL)
    ffn_w_down = nrm(18, (N_DENSE, D_FF, D_MODEL), D_FF)
    router_w = nrm(19, (N_MOE, D_MODEL, N_EXPERTS), D_MODEL)
    exp_w_gate = nrm(20, (N_MOE, N_EXPERTS, D_MODEL, D_FF_EXPERT), D_MODEL)
    exp_w_up = nrm(21, (N_MOE, N_EXPERTS, D_MODEL, D_FF_EXPERT), D_MODEL)
    exp_w_down = nrm(22, (N_MOE, N_EXPERTS, D_FF_EXPERT, D_MODEL), D_FF_EXPERT)
    final_norm_w = gain(23, (D_MODEL,))
    return {'x': x, 'attn_norm_w': attn_norm_w, 'w_in': w_in, 'conv_w': conv_w, 'conv_b': conv_b,
            'a_log': a_log, 'dt_bias': dt_bias, 'd_skip': d_skip, 'ssm_norm_w': ssm_norm_w,
            'na_rpb': na_rpb, 'mla_q_norm_w': mla_q_norm_w, 'mla_kv_norm_w': mla_kv_norm_w,
            'mla_w_uq': mla_w_uq, 'mla_w_ukv': mla_w_ukv, 'w_o': w_o, 'ffn_norm_w': ffn_norm_w,
            'ffn_w_gate': ffn_w_gate, 'ffn_w_up': ffn_w_up, 'ffn_w_down': ffn_w_down,
            'router_w': router_w, 'exp_w_gate': exp_w_gate, 'exp_w_up': exp_w_up,
            'exp_w_down': exp_w_down, 'final_norm_w': final_norm_w}


def reference(x, attn_norm_w, w_in, conv_w, conv_b, a_log, dt_bias, d_skip, ssm_norm_w, na_rpb,
              mla_q_norm_w, mla_kv_norm_w, mla_w_uq, mla_w_ukv, w_o, ffn_norm_w, ffn_w_gate, ffn_w_up,
              ffn_w_down, router_w, exp_w_gate, exp_w_up, exp_w_down, final_norm_w):
    b, t, _ = x.shape
    pos = jnp.arange(t, dtype=jnp.float32)
    split_points = [int(s) for s in np.cumsum(IN_SIZES)[:-1]]
    for l in range(DEPTH):
        h = rms_norm(x, attn_norm_w[l])
        proj = h @ w_in[l]
        (z, xbc, dt_raw, na_q, na_k, na_v, c_q, c_kv, k_rope,
         dl_q, dl_k, dl_v) = jnp.split(proj, split_points, axis=-1)
        y_ssm = mamba2_bidirectional(z, xbc, dt_raw, conv_w[l], conv_b[l], a_log[l], dt_bias[l],
                                     d_skip[l], ssm_norm_w[l])
        y_na = neighborhood_attention(split_heads(na_q, NA_HEADS), split_heads(na_k, NA_HEADS),
                                      split_heads(na_v, NA_HEADS), na_rpb[l]).reshape(b, t, -1)
        y_mla = mla_mixer(c_q, c_kv, k_rope, mla_q_norm_w[l], mla_kv_norm_w[l], mla_w_uq[l],
                          mla_w_ukv[l], pos).reshape(b, t, -1)
        y_dil = dilated_mixer(rope(split_heads(dl_q, DIL_HEADS), pos), rope(split_heads(dl_k, DIL_HEADS), pos),
                              split_heads(dl_v, DIL_HEADS)).reshape(b, t, -1)
        mixed = jnp.concatenate([y_ssm, y_na, y_mla, y_dil], axis=-1)
        x = x + mixed @ w_o[l]
        h = rms_norm(x, ffn_norm_w[l])
        j = l // 2
        if l % 2 == 0:
            x = x + swiglu(h, ffn_w_gate[j], ffn_w_up[j], ffn_w_down[j])
        else:
            x = x + moe_swiglu(h, router_w[j], exp_w_gate[j], exp_w_up[j], exp_w_down[j])
    return rms_norm(x, final_norm_w)
```

```cpp
#include <hip/hip_runtime.h>
#if !defined(DENSE_DOWN_BF16) && !defined(DENSE_F8) && !defined(DENSE_DOWN_F8)
#define DENSE_DOWN_F8 1
#endif
#include <cstdio>
#include <cstdint>

#define LAS __attribute__((address_space(3)))
#define GAS __attribute__((address_space(1)))
typedef unsigned short bf16_t;
typedef short bf16x8 __attribute__((ext_vector_type(8)));
typedef short s16x4 __attribute__((ext_vector_type(4)));
typedef float f32x2 __attribute__((ext_vector_type(2)));
typedef float f32x4 __attribute__((ext_vector_type(4)));
typedef float f32x16 __attribute__((ext_vector_type(16)));
typedef unsigned u32x2 __attribute__((ext_vector_type(2)));
typedef unsigned u32x4 __attribute__((ext_vector_type(4)));

constexpr int NB = 4, T = 4096, M = NB * T, D = 2048, DIN = 5680, DINP = 5888, FF = 5632, NE = 8, DEPTH = 2;
constexpr int C_Z = 0, C_XBC = 512, C_NAQ = 1536, C_NAK = 2048, C_NAV = 2560, C_CQ = 3072, C_CKV = 3584, C_DLQ = 4096, C_DLK = 4608, C_DLV = 5120, C_KR = 5632, C_DT = 5664;
constexpr int HGROWS = 34816;
constexpr float NORM_EPS = 1e-6f;
constexpr float Y0SCALE = 16.0f;
constexpr float LOG2E = 1.4426950408889634f;

constexpr size_t MiB = 1u << 20;
constexpr size_t WS_CTL = 0, CTL_ZERO_BYTES = 1 * MiB;
constexpr size_t WS_ROPE = 1 * MiB;
constexpr size_t WS_ROUTE = 2 * MiB;
constexpr size_t WS_HISTO = 2 * MiB + 256 * 1024;
constexpr size_t WS_TP = WS_HISTO + 16 * 1024;
constexpr size_t WS_ROWTOK = 2 * MiB + 512 * 1024;
constexpr size_t WS_ROWGATE = 2 * MiB + 768 * 1024;
constexpr size_t WS_CDEC = 3 * MiB;
constexpr size_t WS_W = 4 * MiB;
constexpr size_t SZ_WIN = (size_t)DINP * D * 2, SZ_WO = (size_t)D * D * 2, SZ_WUQKV = (size_t)1792 * 512 * 2, SZ_WGU = (size_t)2 * FF * D * 2, SZ_WDN = (size_t)D * FF * 2;
constexpr size_t WS_WIN = WS_W, WS_WO = WS_WIN + 2 * SZ_WIN, WS_WUQKV = WS_WO + 2 * SZ_WO, WS_WGU = WS_WUQKV + 4 * MiB, WS_WDN = WS_WGU + SZ_WGU;
constexpr size_t SZ_WGU8 = SZ_WGU / 2, SZ_WDN8 = SZ_WDN / 2;
constexpr float WSCALE8 = 64.0f;
constexpr size_t WS_WEGU = WS_WDN + SZ_WDN, WS_WEDN = WS_WEGU + NE * SZ_WGU, WS_WEND = WS_WEDN + NE * SZ_WDN;
constexpr size_t WS_X = 664 * MiB, WS_H = 792 * MiB, WS_AR = 856 * MiB;
static_assert(WS_WEND <= WS_X, "weights overflow");
constexpr size_t AR_PROJ = WS_AR, AR_XBC = WS_AR + 184 * MiB, AR_DT = WS_AR + 216 * MiB, AR_CS = WS_AR + 217 * MiB, AR_ST = WS_AR + 218 * MiB, AR_PREV = WS_AR + 282 * MiB;
constexpr size_t AR_QMLA = WS_AR + 314 * MiB, AR_KV = WS_AR + 338 * MiB, AR_DILP = WS_AR + 370 * MiB, AR_DLSE = WS_AR + 418 * MiB, AR_MIXED = WS_AR + 420 * MiB;
constexpr size_t AR_HG = WS_AR, AR_Y0 = WS_AR, AR_HIDE = WS_AR + 136 * MiB;
constexpr size_t WS_END = WS_AR + 510 * MiB;
static_assert((size_t)M * DINP * 2 <= 184 * MiB && (size_t)HGROWS * D * 2 <= 136 * MiB && (size_t)HGROWS * FF * 2 <= 374 * MiB, "arena");

#ifndef NORM_FOLD
#define NORM_FOLD 1
#endif
constexpr size_t WS_PART = 3 * MiB + 512 * 1024;
#ifndef STATS_FUSED
#define STATS_FUSED 1
#endif
constexpr size_t WS_RSTD2 = 640 * 1024;
constexpr size_t WS_RSTD = 512 * 1024;
constexpr int LDS_BYTES = 159744;
constexpr int LDS_MISC = LDS_BYTES - 256;

__device__ __forceinline__ unsigned cvt_pk_bf16(float lo, float hi) { unsigned r; asm volatile("v_cvt_pk_bf16_f32 %0, %1, %2" : "=v"(r) : "v"(lo), "v"(hi)); return r; }
__device__ __forceinline__ float bf_lo(unsigned w) { return __uint_as_float(w << 16); }
__device__ __forceinline__ float bf_hi(unsigned w) { return __uint_as_float(w & 0xffff0000u); }
__device__ __forceinline__ float bf2f(bf16_t b) { return __uint_as_float(((unsigned)b) << 16); }
template <int O> __device__ __forceinline__ int swz_xor_i(int v) { return __builtin_amdgcn_ds_swizzle(v, (O << 10) | 0x1F); }
template <int O> __device__ __forceinline__ float swz_xor(float v) { return __int_as_float(__builtin_amdgcn_ds_swizzle(__float_as_int(v), (O << 10) | 0x1F)); }
__device__ __forceinline__ float xhalf_sum(float v) { auto rr = __builtin_amdgcn_permlane32_swap(__float_as_uint(v), __float_as_uint(v), false, false); return __uint_as_float(rr[0]) + __uint_as_float(rr[1]); }
__device__ __forceinline__ float xhalf_max(float v) { auto rr = __builtin_amdgcn_permlane32_swap(__float_as_uint(v), __float_as_uint(v), false, false); return fmaxf(__uint_as_float(rr[0]), __uint_as_float(rr[1])); }
__device__ __forceinline__ int xhalf_sum_i(int v) { auto rr = __builtin_amdgcn_permlane32_swap((unsigned)v, (unsigned)v, false, false); return (int)(rr[0] + rr[1]); }
__device__ __forceinline__ float wave_sum(float v) {
    v += swz_xor<1>(v); v += swz_xor<2>(v); v += swz_xor<4>(v); v += swz_xor<8>(v); v += swz_xor<16>(v);
    return xhalf_sum(v);
}
__device__ __forceinline__ int wave_sum_i(int v) {
    v += swz_xor_i<1>(v); v += swz_xor_i<2>(v); v += swz_xor_i<4>(v); v += swz_xor_i<8>(v); v += swz_xor_i<16>(v);
    return xhalf_sum_i(v);
}
__device__ __forceinline__ float silu_f(float x) { return x * __builtin_amdgcn_rcpf(1.0f + __builtin_amdgcn_exp2f(-1.4426950408889634f * x)); }
__device__ __forceinline__ int crow(int r, int hi) { return (r & 3) + 8 * (r >> 2) + 4 * hi; }
typedef short v4i16_t __attribute__((ext_vector_type(4)));
__device__ __forceinline__ s16x4 trr(LAS const char* p) { return __builtin_bit_cast(s16x4, __builtin_amdgcn_ds_read_tr16_b64_v4i16((LAS v4i16_t*)p)); }
__device__ __forceinline__ bf16x8 cat8(s16x4 lo, s16x4 hi) { return (bf16x8){lo[0], lo[1], lo[2], lo[3], hi[0], hi[1], hi[2], hi[3]}; }
#define LDS_WAIT() asm volatile("s_waitcnt lgkmcnt(0)" ::: "memory")
#define VM_WAIT() asm volatile("s_waitcnt vmcnt(0)" ::: "memory")

namespace pg8 {
constexpr int BM = 256, BK = 64, HALF = 128, HTB = HALF * BK * 2, STAGE_BYTES = 8 * HTB, NXCD = 8;
__host__ __device__ __forceinline__ int lds_byte(int r, int c) { const int st = (r >> 4) * 2 + (c >> 5), rr = r & 15, cc = c & 31, ob = rr * 64 + cc * 2; return st * 1024 + (ob ^ (((ob >> 9) & 1) << 5)); }
__host__ __device__ __forceinline__ void stage_rc(int b, int& R, int& C) { const int st = b / 1024, sb = b % 1024, swz = sb ^ (((sb >> 9) & 1) << 5); R = (st >> 1) * 16 + swz / 64; C = (st & 1) * 32 + (swz % 64) / 2; }
__host__ __device__ __forceinline__ int perm32(int rho) { const int n = rho >> 4, i = rho & 15; return 8 * (i >> 2) + 4 * n + (i & 3); }

typedef int i32x4 __attribute__((ext_vector_type(4)));
typedef int i32x8 __attribute__((ext_vector_type(8)));
__device__ __forceinline__ i32x8 cat_f8(bf16x8 lo, bf16x8 hi) { const i32x4 a = __builtin_bit_cast(i32x4, lo), b = __builtin_bit_cast(i32x4, hi); return __builtin_shufflevector(a, b, 0, 1, 2, 3, 4, 5, 6, 7); }
struct Unit { int pm, pn, e; const char* a; const char* b; };
struct Gemm { int lda, ldb, K; };

template <int WGMT>
__device__ __forceinline__ bool tile_of(int i, int G, int c, int nM, int nN, int& pm, int& pn) {
    constexpr int WGM = WGMT;
    const int nwg = nM * nN; const long L = (long)i * G + c; if (L >= nwg) return false;
    int wgid = (int)L; { const int q = nwg / NXCD, r = nwg % NXCD, xcd = wgid % NXCD, off = wgid / NXCD; wgid = (xcd < r ? xcd * (q + 1) : r * (q + 1) + (xcd - r) * q) + off; }
    const int nig = WGM * nN, gid = wgid / nig, fm = gid * WGM, gsz = (nM - fm) < WGM ? (nM - fm) : WGM;
    pm = fm + ((wgid % nig) % gsz); pn = (wgid % nig) / gsz; return true;
}
template <int WGMT>
struct PlainSched {
    static constexpr bool GATHER = false;
    int nM, nN, G, c; const char* A; const char* B; size_t tA, tB;
    __device__ __forceinline__ void gather(const Unit&, int, unsigned (&)[2][2]) const {}
    __device__ __forceinline__ bool next(int i, Unit& u) const { if (!tile_of<WGMT>(i, G, c, nM, nN, u.pm, u.pn)) return false; u.e = i  ; u.a = A + (size_t)u.pm * tA; u.b = B + (size_t)u.pn * tB; return true; }
};

template <bool F8, class Epi, class Sched>
__device__ __forceinline__ void gemm_phase(LAS unsigned char* lds, const int tid, const Gemm g, const Sched& S, const Epi& E) {
    const int wid = __builtin_amdgcn_readfirstlane(tid >> 6), lane = tid & 63, wr = wid >> 2, wc = wid & 3, fr = lane & 15, fq = lane >> 4;
    const int K = g.K, nt = K / BK;
    unsigned voffA[2], voffB[2];
#pragma unroll
    for (int i = 0; i < 2; ++i) { int R, C; stage_rc(tid * 16 + i * 8192, R, C); const int Rb = Epi::PERM ? ((R & ~31) + perm32(R & 31)) : R;
        voffA[i] = (unsigned)(R * g.lda + C) * 2u; voffB[i] = (unsigned)(Rb * g.ldb + C) * 2u; }
    const size_t kstep = (size_t)(BK * 2);
    const size_t hA = (size_t)HALF * g.lda * 2, hB = (size_t)HALF * g.ldb * 2;
    const unsigned ldsw = (unsigned)wid * 1024u;
    const int aoff = lds_byte(wr * 64 + fr, fq * 8), boff = lds_byte(wc * 32 + fr, fq * 8);
#define PG8_SA(b, h) (((b) * 2 + (h)) * HTB)
#define PG8_SB(b, h) ((4 + (b) * 2 + (h)) * HTB)
#define PG8_STAGE(bufoff, gbase, voff) do { _Pragma("unroll") for (int _i = 0; _i < 2; ++_i) \
        __builtin_amdgcn_global_load_lds((const unsigned*)((const char*)(gbase) + (voff)[_i]), (LAS unsigned*)(lds + (bufoff) + ldsw + _i * 8192), 16, 0, 0); } while (0)
#define PG8_STAGEA(bufoff, gptr, half, NX) do { if constexpr (Sched::GATHER) { _Pragma("unroll") for (int _i = 0; _i < 2; ++_i) { const unsigned _o = (NX) ? gAn[half][_i] : gAc[half][_i]; \
        __builtin_amdgcn_global_load_lds((const unsigned*)((const char*)(gptr) + _o), (LAS unsigned*)(lds + (bufoff) + ldsw + _i * 8192), 16, 0, 0); } } \
    else PG8_STAGE(bufoff, (const char*)(gptr) + ((half) ? hA : (size_t)0), voffA); } while (0)
#define PG8_LDA(dst, b, h) do { _Pragma("unroll") for (int m = 0; m < 4; ++m) { const i32x4 _x0 = *(const LAS i32x4*)(lds + PG8_SA(b, h) + aoff + m * 2048), _x1 = *(const LAS i32x4*)(lds + PG8_SA(b, h) + aoff + m * 2048 + 1024); dst[m] = __builtin_shufflevector(_x0, _x1, 0, 1, 2, 3, 4, 5, 6, 7); } } while (0)
#define PG8_LDB(dst, b, h) do { _Pragma("unroll") for (int n = 0; n < 2; ++n) { const i32x4 _x0 = *(const LAS i32x4*)(lds + PG8_SB(b, h) + boff + n * 2048), _x1 = *(const LAS i32x4*)(lds + PG8_SB(b, h) + boff + n * 2048 + 1024); dst[n] = __builtin_shufflevector(_x0, _x1, 0, 1, 2, 3, 4, 5, 6, 7); } } while (0)
#define PG8_K0(x) __builtin_bit_cast(bf16x8, __builtin_shufflevector(x, x, 0, 1, 2, 3))
#define PG8_K1(x) __builtin_bit_cast(bf16x8, __builtin_shufflevector(x, x, 4, 5, 6, 7))
#define PG8_MMA(ai, bj, At, Bt) do { __builtin_amdgcn_s_setprio(1); _Pragma("unroll") for (int m = 0; m < 4; ++m) _Pragma("unroll") for (int n = 0; n < 2; ++n) { \
        if constexpr (F8) { asm volatile("v_mfma_scale_f32_16x16x128_f8f6f4 %0, %1, %2, %0, %3, %3 op_sel_hi:[0,0,0]" : "+v"(acc[ai][bj][m][n]) : "v"(Bt[n]), "v"(At[m]), "v"(sc8)); } \
        else { acc[ai][bj][m][n] = __builtin_amdgcn_mfma_f32_16x16x32_bf16(PG8_K0(Bt[n]), PG8_K0(At[m]), acc[ai][bj][m][n], 0, 0, 0); \
               acc[ai][bj][m][n] = __builtin_amdgcn_mfma_f32_16x16x32_bf16(PG8_K1(Bt[n]), PG8_K1(At[m]), acc[ai][bj][m][n], 0, 0, 0); } } __builtin_amdgcn_s_setprio(0); } while (0)
#define PG8_WAIT_V(n) asm volatile("s_waitcnt vmcnt(" #n ")" ::: "memory")
#define PG8_WAIT_L(n) asm volatile("s_waitcnt lgkmcnt(" #n ")" ::: "memory")
#define PG8_BAR __builtin_amdgcn_s_barrier()
#define PG8_SCHED __builtin_amdgcn_sched_barrier(0)
    Unit cur, nxt; int ui = 0;
    if (!S.next(0, cur)) return;
    f32x4 acc[2][2][4][2];
#pragma unroll
    for (int a = 0; a < 2; ++a)
#pragma unroll
        for (int b = 0; b < 2; ++b)
#pragma unroll
            for (int m = 0; m < 4; ++m)
#pragma unroll
                for (int n = 0; n < 2; ++n) acc[a][b][m][n] = (f32x4){0.f, 0.f, 0.f, 0.f};
    i32x8 At[4], B0[2], B1[2];
    int sc8 = 0x7F7F7F7F; asm volatile("" : "+v"(sc8));
    const char* cA = cur.a; const char* cB = cur.b;
    unsigned gAc[2][2] = {{0u, 0u}, {0u, 0u}}, gAn[2][2] = {{0u, 0u}, {0u, 0u}};
    if constexpr (Sched::GATHER) S.gather(cur, tid, gAc);
    PG8_STAGE(PG8_SB(0, 0), cB, voffB); PG8_STAGE(PG8_SB(0, 1), cB + hB, voffB); PG8_STAGEA(PG8_SA(0, 0), cA, 0, false); PG8_STAGEA(PG8_SA(0, 1), cA, 1, false);
    if (wr == 1) PG8_BAR;
    PG8_WAIT_V(2); PG8_BAR;
    PG8_STAGE(PG8_SB(1, 0), cB + kstep, voffB); PG8_STAGEA(PG8_SA(1, 0), cA + kstep, 0, false); PG8_STAGE(PG8_SB(1, 1), cB + hB + kstep, voffB);
    PG8_WAIT_V(6); PG8_BAR;
    for (;;) {
        const bool has_next = S.next(ui + 1, nxt);
        if constexpr (Sched::GATHER) { if (has_next) S.gather(nxt, tid, gAn); else { gAn[0][0] = gAc[0][0]; gAn[0][1] = gAc[0][1]; gAn[1][0] = gAc[1][0]; gAn[1][1] = gAc[1][1]; } }
        const char* nA = has_next ? nxt.a : cA; const char* nB = has_next ? nxt.b : cB;
#pragma unroll 1
        for (int t = 0; t < nt; t += 2) {
            const bool last = (t == nt - 2);
            const char* a1 = cA + (size_t)(t + 1) * kstep;
            const char* a2 = last ? nA : cA + (size_t)(t + 2) * kstep; const char* b2 = last ? nB : cB + (size_t)(t + 2) * kstep;
            const char* a3 = a2 + kstep; const char* b3 = b2 + kstep;
            PG8_LDB(B0, 0, 0); PG8_LDB(B1, 0, 1); PG8_SCHED; PG8_LDA(At, 0, 0); PG8_STAGEA(PG8_SA(1, 1), a1, 1, false);
            PG8_WAIT_V(8); PG8_WAIT_L(0); PG8_BAR; PG8_MMA(0, 0, At, B0); PG8_MMA(0, 1, At, B1); PG8_BAR; PG8_SCHED;
            PG8_LDA(At, 0, 1); PG8_STAGE(PG8_SB(0, 0), b2, voffB); PG8_STAGE(PG8_SB(0, 1), b2 + hB, voffB); PG8_STAGEA(PG8_SA(0, 0), a2, 0, last);
            PG8_WAIT_V(8); PG8_WAIT_L(0); PG8_BAR; PG8_MMA(1, 0, At, B0); PG8_MMA(1, 1, At, B1); PG8_BAR; PG8_SCHED;
            PG8_LDB(B0, 1, 0); PG8_LDB(B1, 1, 1); PG8_SCHED; PG8_LDA(At, 1, 0); PG8_STAGEA(PG8_SA(0, 1), a2, 1, last);
            PG8_WAIT_V(8); PG8_WAIT_L(0); PG8_BAR; PG8_MMA(0, 0, At, B0); PG8_MMA(0, 1, At, B1); PG8_BAR; PG8_SCHED;
            PG8_LDA(At, 1, 1); PG8_STAGE(PG8_SB(1, 0), b3, voffB); PG8_STAGE(PG8_SB(1, 1), b3 + hB, voffB); PG8_STAGEA(PG8_SA(1, 0), a3, 0, last);
            PG8_WAIT_V(8); PG8_WAIT_L(0); PG8_BAR; PG8_MMA(1, 0, At, B0); PG8_MMA(1, 1, At, B1); PG8_BAR; PG8_SCHED;
        }
        if constexpr (F8) asm volatile("s_nop 15\n\ts_nop 15" ::: "memory");
#ifndef NO_ALIGN_EPI
        if (wr == 0) PG8_BAR;
#endif
        E(acc, cur, wr, wc, fr, fq);
        if (!has_next) break;
#pragma unroll
        for (int a = 0; a < 2; ++a)
#pragma unroll
            for (int b = 0; b < 2; ++b)
#pragma unroll
                for (int m = 0; m < 4; ++m)
#pragma unroll
                    for (int n = 0; n < 2; ++n) acc[a][b][m][n] = (f32x4){0.f, 0.f, 0.f, 0.f};
        cur = nxt; cA = nA; cB = nB; ++ui;
        if constexpr (Sched::GATHER) { gAc[0][0] = gAn[0][0]; gAc[0][1] = gAn[0][1]; gAc[1][0] = gAn[1][0]; gAc[1][1] = gAn[1][1]; }
#ifndef NO_ALIGN_EPI
        if (wr == 1) PG8_BAR;
#endif
    }
    PG8_WAIT_V(0);
#ifdef NO_ALIGN_EPI
    if (wr == 0) PG8_BAR;
#endif
    PG8_BAR;
#undef PG8_SA
#undef PG8_SB
#undef PG8_STAGE
#undef PG8_STAGEA
#undef PG8_LDA
#undef PG8_LDB
#undef PG8_MMA
#undef PG8_K0
#undef PG8_K1
#undef PG8_WAIT_V
#undef PG8_WAIT_L
#undef PG8_BAR
#undef PG8_SCHED
}

struct EpiBf16 {
    static constexpr bool PERM = true;
    bf16_t* O; int ldc;
    __device__ __forceinline__ void operator()(const f32x4 (&acc)[2][2][4][2], const Unit& u, int wr, int wc, int fr, int fq) const {
        const int row0 = u.pm * BM + wr * 64 + fr, col0 = u.pn * BM + wc * 32 + 8 * fq;
#pragma unroll
        for (int ai = 0; ai < 2; ++ai)
#pragma unroll
            for (int m = 0; m < 4; ++m) { bf16_t* rowp = O + (size_t)(row0 + ai * HALF + m * 16) * ldc + col0;
#pragma unroll
                for (int bj = 0; bj < 2; ++bj) { const f32x4 v0 = acc[ai][bj][m][0], v1 = acc[ai][bj][m][1];
                    u32x4 w; w.x = cvt_pk_bf16(v0[0], v0[1]); w.y = cvt_pk_bf16(v0[2], v0[3]); w.z = cvt_pk_bf16(v1[0], v1[1]); w.w = cvt_pk_bf16(v1[2], v1[3]);
                    *(u32x4*)(rowp + bj * HALF) = w; } }
    }
};
struct EpiBf16R {
    static constexpr bool PERM = true;
    bf16_t* O; int ldc; const float* rs;
    __device__ __forceinline__ void operator()(const f32x4 (&acc)[2][2][4][2], const Unit& u, int wr, int wc, int fr, int fq) const {
        const int row0 = u.pm * BM + wr * 64 + fr, col0 = u.pn * BM + wc * 32 + 8 * fq;
        float rv[2][4];
#pragma unroll
        for (int ai = 0; ai < 2; ++ai)
#pragma unroll
            for (int m = 0; m < 4; ++m) rv[ai][m] = rs[row0 + ai * HALF + m * 16];
        asm volatile("" ::: "memory");
#pragma unroll
        for (int ai = 0; ai < 2; ++ai)
#pragma unroll
            for (int m = 0; m < 4; ++m) { bf16_t* rowp = O + (size_t)(row0 + ai * HALF + m * 16) * ldc + col0; const float r = rv[ai][m];
#pragma unroll
                for (int bj = 0; bj < 2; ++bj) { const f32x4 v0 = acc[ai][bj][m][0] * r, v1 = acc[ai][bj][m][1] * r;
                    u32x4 w; w.x = cvt_pk_bf16(v0[0], v0[1]); w.y = cvt_pk_bf16(v0[2], v0[3]); w.z = cvt_pk_bf16(v1[0], v1[1]); w.w = cvt_pk_bf16(v1[2], v1[3]);
                    *(u32x4*)(rowp + bj * HALF) = w; } }
    }
};
struct EpiBf16R2 {
    static constexpr bool PERM = true;
    bf16_t* O; int ldc; const float* rs2;
    __device__ __forceinline__ void operator()(const f32x4 (&acc)[2][2][4][2], const Unit& u, int wr, int wc, int fr, int fq) const {
        const int row0 = u.pm * BM + wr * 64 + fr, col0 = u.pn * BM + wc * 32 + 8 * fq, sel = u.pn >= 3 ? 1 : 0;
        float rv[2][4];
#pragma unroll
        for (int ai = 0; ai < 2; ++ai)
#pragma unroll
            for (int m = 0; m < 4; ++m) rv[ai][m] = rs2[(size_t)(row0 + ai * HALF + m * 16) * 2 + sel];
        asm volatile("" ::: "memory");
#pragma unroll
        for (int ai = 0; ai < 2; ++ai)
#pragma unroll
            for (int m = 0; m < 4; ++m) { bf16_t* rowp = O + (size_t)(row0 + ai * HALF + m * 16) * ldc + col0; const float r = rv[ai][m];
#pragma unroll
                for (int bj = 0; bj < 2; ++bj) { const f32x4 v0 = acc[ai][bj][m][0] * r, v1 = acc[ai][bj][m][1] * r;
                    u32x4 w; w.x = cvt_pk_bf16(v0[0], v0[1]); w.y = cvt_pk_bf16(v0[2], v0[3]); w.z = cvt_pk_bf16(v1[0], v1[1]); w.w = cvt_pk_bf16(v1[2], v1[3]);
                    *(u32x4*)(rowp + bj * HALF) = w; } }
    }
};
struct EpiMla {
    static constexpr bool PERM = true;
    bf16_t* Q; bf16_t* KV;
    __device__ __forceinline__ void operator()(const f32x4 (&acc)[2][2][4][2], const Unit& u, int wr, int wc, int fr, int fq) const {
        const bool isq = u.pn < 3; bf16_t* O = isq ? Q : KV; const int ldc = isq ? 768 : 1024; const int pn = isq ? u.pn : u.pn - 3;
        const int row0 = u.pm * BM + wr * 64 + fr, col0 = pn * BM + wc * 32 + 8 * fq;
#pragma unroll
        for (int ai = 0; ai < 2; ++ai)
#pragma unroll
            for (int m = 0; m < 4; ++m) { bf16_t* rowp = O + (size_t)(row0 + ai * HALF + m * 16) * ldc + col0;
#pragma unroll
                for (int bj = 0; bj < 2; ++bj) { const f32x4 v0 = acc[ai][bj][m][0], v1 = acc[ai][bj][m][1];
                    u32x4 w; w.x = cvt_pk_bf16(v0[0], v0[1]); w.y = cvt_pk_bf16(v0[2], v0[3]); w.z = cvt_pk_bf16(v1[0], v1[1]); w.w = cvt_pk_bf16(v1[2], v1[3]);
                    *(u32x4*)(rowp + bj * HALF) = w; } }
    }
};
#ifndef EPI_RB
#define EPI_RB 2
#endif
struct EpiResF32 {
    static constexpr bool PERM = false;
    const float* base; float* out; float scale;
    __device__ __forceinline__ void operator()(const f32x4 (&acc)[2][2][4][2], const Unit& u, int wr, int wc, int fr, int fq) const {
        const int row0 = u.pm * BM + wr * 64 + fr, col0 = u.pn * BM + wc * 32 + 4 * fq;
#pragma unroll
        for (int ai = 0; ai < 2; ++ai)
#pragma unroll
            for (int m0 = 0; m0 < 4; m0 += EPI_RB) { f32x4 bs[EPI_RB][2][2];
#pragma unroll
                for (int mi = 0; mi < EPI_RB; ++mi) { const size_t off = (size_t)(row0 + ai * HALF + (m0 + mi) * 16) * D + col0;
#pragma unroll
                    for (int bj = 0; bj < 2; ++bj)
#pragma unroll
                        for (int n = 0; n < 2; ++n) bs[mi][bj][n] = *(const f32x4*)(base + off + bj * HALF + n * 16); }
                asm volatile("" ::: "memory");
#pragma unroll
                for (int mi = 0; mi < EPI_RB; ++mi) { const size_t off = (size_t)(row0 + ai * HALF + (m0 + mi) * 16) * D + col0;
#pragma unroll
                    for (int bj = 0; bj < 2; ++bj)
#pragma unroll
                        for (int n = 0; n < 2; ++n) *(f32x4*)(out + off + bj * HALF + n * 16) = bs[mi][bj][n] + acc[ai][bj][m0 + mi][n] * scale; }
                asm volatile("" ::: "memory"); }
    }
};
template <class BT>
struct EpiResB16 {
    static constexpr bool PERM = true;
    const BT* base; bf16_t* out; float scale;
    __device__ __forceinline__ void operator()(const f32x4 (&acc)[2][2][4][2], const Unit& u, int wr, int wc, int fr, int fq) const {
        const int row0 = u.pm * BM + wr * 64 + fr, col0 = u.pn * BM + wc * 32 + 8 * fq;
#pragma unroll
        for (int ai = 0; ai < 2; ++ai)
#pragma unroll
            for (int m0 = 0; m0 < 4; m0 += EPI_RB) { f32x4 bs[EPI_RB][2][2];
#pragma unroll
                for (int mi = 0; mi < EPI_RB; ++mi) { const size_t off = (size_t)(row0 + ai * HALF + (m0 + mi) * 16) * D + col0;
#pragma unroll
                    for (int bj = 0; bj < 2; ++bj) {
                        if constexpr (sizeof(BT) == 4) { bs[mi][bj][0] = *(const f32x4*)((const float*)base + off + bj * HALF); bs[mi][bj][1] = *(const f32x4*)((const float*)base + off + bj * HALF + 4); }
                        else { const u32x4 x = *(const u32x4*)((const bf16_t*)base + off + bj * HALF); bs[mi][bj][0] = (f32x4){bf_lo(x.x), bf_hi(x.x), bf_lo(x.y), bf_hi(x.y)}; bs[mi][bj][1] = (f32x4){bf_lo(x.z), bf_hi(x.z), bf_lo(x.w), bf_hi(x.w)}; } } }
                asm volatile("" ::: "memory");
#pragma unroll
                for (int mi = 0; mi < EPI_RB; ++mi) { const size_t off = (size_t)(row0 + ai * HALF + (m0 + mi) * 16) * D + col0;
#pragma unroll
                    for (int bj = 0; bj < 2; ++bj) { const f32x4 v0 = bs[mi][bj][0] + acc[ai][bj][m0 + mi][0] * scale, v1 = bs[mi][bj][1] + acc[ai][bj][m0 + mi][1] * scale;
                        u32x4 w; w.x = cvt_pk_bf16(v0[0], v0[1]); w.y = cvt_pk_bf16(v0[2], v0[3]); w.z = cvt_pk_bf16(v1[0], v1[1]); w.w = cvt_pk_bf16(v1[2], v1[3]);
                        *(u32x4*)(out + off + bj * HALF) = w; } }
                asm volatile("" ::: "memory"); }
    }
};
constexpr int LDS_SS_OFF = 131072, LDS_LRS_OFF = 131072 + 4096;
struct EpiResB16S {
    static constexpr bool PERM = true;
    const bf16_t* base; bf16_t* out; float scale; float* part; LAS float* lss;
    __device__ __forceinline__ void operator()(const f32x4 (&acc)[2][2][4][2], const Unit& u, int wr, int wc, int fr, int fq) const {
        const int row0 = u.pm * BM + wr * 64 + fr, col0 = u.pn * BM + wc * 32 + 8 * fq;
        float ssr[2][4];
#pragma unroll
        for (int ai = 0; ai < 2; ++ai)
#pragma unroll
            for (int m = 0; m < 4; ++m) ssr[ai][m] = 0.f;
#pragma unroll
        for (int ai = 0; ai < 2; ++ai)
#pragma unroll
            for (int m0 = 0; m0 < 4; m0 += EPI_RB) { f32x4 bs[EPI_RB][2][2];
#pragma unroll
                for (int mi = 0; mi < EPI_RB; ++mi) { const size_t off = (size_t)(row0 + ai * HALF + (m0 + mi) * 16) * D + col0;
#pragma unroll
                    for (int bj = 0; bj < 2; ++bj) { const u32x4 x = *(const u32x4*)(base + off + bj * HALF); bs[mi][bj][0] = (f32x4){bf_lo(x.x), bf_hi(x.x), bf_lo(x.y), bf_hi(x.y)}; bs[mi][bj][1] = (f32x4){bf_lo(x.z), bf_hi(x.z), bf_lo(x.w), bf_hi(x.w)}; } }
                asm volatile("" ::: "memory");
#pragma unroll
                for (int mi = 0; mi < EPI_RB; ++mi) { const size_t off = (size_t)(row0 + ai * HALF + (m0 + mi) * 16) * D + col0; float ss = 0.f;
#pragma unroll
                    for (int bj = 0; bj < 2; ++bj) { const f32x4 v0 = bs[mi][bj][0] + acc[ai][bj][m0 + mi][0] * scale, v1 = bs[mi][bj][1] + acc[ai][bj][m0 + mi][1] * scale;
                        u32x4 w; w.x = cvt_pk_bf16(v0[0], v0[1]); w.y = cvt_pk_bf16(v0[2], v0[3]); w.z = cvt_pk_bf16(v1[0], v1[1]); w.w = cvt_pk_bf16(v1[2], v1[3]);
                        *(u32x4*)(out + off + bj * HALF) = w;
                        const unsigned ws4[4] = {w.x, w.y, w.z, w.w};
#pragma unroll
                        for (int q = 0; q < 4; ++q) { const float a0 = bf_lo(ws4[q]), a1 = bf_hi(ws4[q]); ss += a0 * a0 + a1 * a1; } }
                    ssr[ai][m0 + mi] = ss; }
                asm volatile("" ::: "memory"); }
#pragma unroll
        for (int ai = 0; ai < 2; ++ai)
#pragma unroll
            for (int m = 0; m < 4; ++m) { float t = ssr[ai][m]; t += swz_xor<16>(t); t = xhalf_sum(t); if (fq == 0) lss[wc * 256 + wr * 64 + fr + ai * HALF + m * 16] = t; }
        asm volatile("s_waitcnt lgkmcnt(0)" ::: "memory");
        __builtin_amdgcn_s_barrier();
        const int t = (wr * 4 + wc) * 64 + fq * 16 + fr;
        if (t < 256) part[(size_t)(u.pm * BM + t) * 8 + u.pn] = (lss[t] + lss[256 + t]) + (lss[512 + t] + lss[768 + t]);
    }
};
template <class Sched>
__device__ __forceinline__ void fill_lrs(const Sched& S, const float* part, LAS unsigned char* lds, int tid, int max_units) {
    LAS float* lrs = (LAS float*)(lds + LDS_LRS_OFF);
    for (int u0 = 0; u0 < max_units; u0 += 6) {
        f32x4 a[6], b[6]; bool ok[6];
#pragma unroll
        for (int j = 0; j < 6; ++j) { Unit u; ok[j] = (u0 + j < max_units) && S.next(u0 + j, u); a[j] = (f32x4){0.f, 0.f, 0.f, 0.f}; b[j] = a[j];
            if (ok[j] && tid < 256) { const f32x4* p = (const f32x4*)(part + (size_t)(u.pm * BM + tid) * 8); a[j] = p[0]; b[j] = p[1]; } }
#pragma unroll
        for (int j = 0; j < 6; ++j) if (ok[j] && tid < 256) { const float ss = ((a[j].x + a[j].y) + (a[j].z + a[j].w)) + ((b[j].x + b[j].y) + (b[j].z + b[j].w)); lrs[(u0 + j) * 256 + tid] = 1.0f / sqrtf(ss * (1.0f / D) + NORM_EPS); }
        if (!ok[5]) break; }
    __syncthreads();
}
struct EpiBf16RL {
    static constexpr bool PERM = true;
    bf16_t* O; int ldc; LAS const float* lrs;
    __device__ __forceinline__ void operator()(const f32x4 (&acc)[2][2][4][2], const Unit& u, int wr, int wc, int fr, int fq) const {
        const int row0 = u.pm * BM + wr * 64 + fr, col0 = u.pn * BM + wc * 32 + 8 * fq;
#pragma unroll
        for (int ai = 0; ai < 2; ++ai)
#pragma unroll
            for (int m = 0; m < 4; ++m) { bf16_t* rowp = O + (size_t)(row0 + ai * HALF + m * 16) * ldc + col0; const float r = lrs[u.e * 256 + wr * 64 + fr + ai * HALF + m * 16];
#pragma unroll
                for (int bj = 0; bj < 2; ++bj) { const f32x4 v0 = acc[ai][bj][m][0] * r, v1 = acc[ai][bj][m][1] * r;
                    u32x4 w; w.x = cvt_pk_bf16(v0[0], v0[1]); w.y = cvt_pk_bf16(v0[2], v0[3]); w.z = cvt_pk_bf16(v1[0], v1[1]); w.w = cvt_pk_bf16(v1[2], v1[3]);
                    *(u32x4*)(rowp + bj * HALF) = w; } }
    }
};
struct EpiSwiGlu {
    static constexpr bool PERM = true;
    bf16_t* H; const float* rowgate;
    __device__ __forceinline__ void operator()(const f32x4 (&acc)[2][2][4][2], const Unit& u, int wr, int wc, int fr, int fq) const {
        const int row0 = u.pm * BM + wr * 64 + fr, col0 = u.pn * HALF + wc * 32 + 8 * fq;
#pragma unroll
        for (int ai = 0; ai < 2; ++ai)
#pragma unroll
            for (int m = 0; m < 4; ++m) { const int row = row0 + ai * HALF + m * 16; const float rg = rowgate ? rowgate[row] : 1.0f;
                float o[8];
#pragma unroll
                for (int n = 0; n < 2; ++n)
#pragma unroll
                    for (int j = 0; j < 4; ++j) { const float gg = acc[ai][0][m][n][j], uu = acc[ai][1][m][n][j]; o[4 * n + j] = rg * silu_f(gg) * uu; }
                u32x4 w; w.x = cvt_pk_bf16(o[0], o[1]); w.y = cvt_pk_bf16(o[2], o[3]); w.z = cvt_pk_bf16(o[4], o[5]); w.w = cvt_pk_bf16(o[6], o[7]);
                *(u32x4*)(H + (size_t)row * FF + col0) = w; }
    }
};
__device__ __forceinline__ unsigned pk_fp8x4(float a, float b, float c, float d) { int w = __builtin_amdgcn_cvt_pk_fp8_f32(a, b, 0, false); w = __builtin_amdgcn_cvt_pk_fp8_f32(c, d, w, true); return (unsigned)w; }
struct EpiSwiGluF8 {
    static constexpr bool PERM = true;
    unsigned char* H; const float* rowgate; float inv;
    __device__ __forceinline__ void operator()(const f32x4 (&acc)[2][2][4][2], const Unit& u, int wr, int wc, int fr, int fq) const {
        const int row0 = u.pm * BM + wr * 64 + fr, col0 = u.pn * HALF + wc * 32 + 8 * fq;
        float rgv[2][4];
#pragma unroll
        for (int ai = 0; ai < 2; ++ai)
#pragma unroll
            for (int m = 0; m < 4; ++m) rgv[ai][m] = rowgate ? rowgate[row0 + ai * HALF + m * 16] : 1.0f;
        asm volatile("" ::: "memory");
#pragma unroll
        for (int ai = 0; ai < 2; ++ai)
#pragma unroll
            for (int m = 0; m < 4; ++m) { const int row = row0 + ai * HALF + m * 16; const float rg = rgv[ai][m] * inv;
                float o[8];
#pragma unroll
                for (int n = 0; n < 2; ++n)
#pragma unroll
                    for (int j = 0; j < 4; ++j) { const float gg = acc[ai][0][m][n][j] * inv, uu = acc[ai][1][m][n][j]; o[4 * n + j] = rg * silu_f(gg) * uu; }
                *(u32x2*)(H + (size_t)row * FF + col0) = (u32x2){pk_fp8x4(o[0], o[1], o[2], o[3]), pk_fp8x4(o[4], o[5], o[6], o[7])}; }
    }
};
struct EpiSwiGluF8R {
    static constexpr bool PERM = true;
    unsigned char* H; const float* rs;
    __device__ __forceinline__ void operator()(const f32x4 (&acc)[2][2][4][2], const Unit& u, int wr, int wc, int fr, int fq) const {
        const int row0 = u.pm * BM + wr * 64 + fr, col0 = u.pn * HALF + wc * 32 + 8 * fq;
        float rv[2][4];
#pragma unroll
        for (int ai = 0; ai < 2; ++ai)
#pragma unroll
            for (int m = 0; m < 4; ++m) rv[ai][m] = rs[row0 + ai * HALF + m * 16];
        asm volatile("" ::: "memory");
#pragma unroll
        for (int ai = 0; ai < 2; ++ai)
#pragma unroll
            for (int m = 0; m < 4; ++m) { const int row = row0 + ai * HALF + m * 16; const float r = rv[ai][m];
                float o[8];
#pragma unroll
                for (int n = 0; n < 2; ++n)
#pragma unroll
                    for (int j = 0; j < 4; ++j) { const float gg = acc[ai][0][m][n][j] * r, uu = acc[ai][1][m][n][j] * r; o[4 * n + j] = silu_f(gg) * uu; }
                *(u32x2*)(H + (size_t)row * FF + col0) = (u32x2){pk_fp8x4(o[0], o[1], o[2], o[3]), pk_fp8x4(o[4], o[5], o[6], o[7])}; }
    }
};
struct EpiSwiGluF8RL {
    static constexpr bool PERM = true;
    unsigned char* H; LAS const float* lrs;
    __device__ __forceinline__ void operator()(const f32x4 (&acc)[2][2][4][2], const Unit& u, int wr, int wc, int fr, int fq) const {
        const int row0 = u.pm * BM + wr * 64 + fr, col0 = u.pn * HALF + wc * 32 + 8 * fq;
#pragma unroll
        for (int ai = 0; ai < 2; ++ai)
#pragma unroll
            for (int m = 0; m < 4; ++m) { const int row = row0 + ai * HALF + m * 16; const float r = lrs[u.e * 256 + wr * 64 + fr + ai * HALF + m * 16];
                float o[8];
#pragma unroll
                for (int n = 0; n < 2; ++n)
#pragma unroll
                    for (int j = 0; j < 4; ++j) { const float gg = acc[ai][0][m][n][j] * r, uu = acc[ai][1][m][n][j] * r; o[4 * n + j] = silu_f(gg) * uu; }
                *(u32x2*)(H + (size_t)row * FF + col0) = (u32x2){pk_fp8x4(o[0], o[1], o[2], o[3]), pk_fp8x4(o[4], o[5], o[6], o[7])}; }
    }
};
struct EpiMoeDown {
    static constexpr bool PERM = true;
    const int* rowtok; bf16_t* X; bf16_t* Y0; float scale;
    __device__ __forceinline__ void operator()(const f32x4 (&acc)[2][2][4][2], const Unit& u, int wr, int wc, int fr, int fq) const {
        const int row0 = u.pm * BM + wr * 64 + fr, col0 = u.pn * BM + wc * 32 + 8 * fq;
        int rtv[2][4];
#pragma unroll
        for (int ai = 0; ai < 2; ++ai)
#pragma unroll
            for (int m = 0; m < 4; ++m) rtv[ai][m] = rowtok[row0 + ai * HALF + m * 16];
        asm volatile("" ::: "memory");
#pragma unroll
        for (int ai = 0; ai < 2; ++ai)
#pragma unroll
            for (int m = 0; m < 4; ++m) { const int rt = rtv[ai][m];
                if (rt >= 0) { const bool second = rt >= M; const int tok = second ? rt - M : rt;
                    if (second) { bf16_t* dst = X + (size_t)tok * D + col0; u32x4 bs[2];
#pragma unroll
                        for (int bj = 0; bj < 2; ++bj) bs[bj] = *(const u32x4*)(dst + bj * HALF);
                        asm volatile("" ::: "memory");
#pragma unroll
                        for (int bj = 0; bj < 2; ++bj) { const u32x4 x = bs[bj]; const f32x4 v0 = acc[ai][bj][m][0] * scale + (f32x4){bf_lo(x.x), bf_hi(x.x), bf_lo(x.y), bf_hi(x.y)}, v1 = acc[ai][bj][m][1] * scale + (f32x4){bf_lo(x.z), bf_hi(x.z), bf_lo(x.w), bf_hi(x.w)};
                            u32x4 w; w.x = cvt_pk_bf16(v0[0], v0[1]); w.y = cvt_pk_bf16(v0[2], v0[3]); w.z = cvt_pk_bf16(v1[0], v1[1]); w.w = cvt_pk_bf16(v1[2], v1[3]);
                            *(u32x4*)(dst + bj * HALF) = w; } }
                    else { unsigned char* dst = (unsigned char*)Y0 + (size_t)tok * D + col0;
                        const float s8 = scale * Y0SCALE;
#pragma unroll
                        for (int bj = 0; bj < 2; ++bj) { const f32x4 v0 = acc[ai][bj][m][0] * s8, v1 = acc[ai][bj][m][1] * s8;
                            *(u32x2*)(dst + bj * HALF) = (u32x2){pk_fp8x4(v0[0], v0[1], v0[2], v0[3]), pk_fp8x4(v1[0], v1[1], v1[2], v1[3])}; } } } }
    }
};
}

#define XB_TMO      128
#define XB_XCNT(j)  (256  + 64 * (j))
#define XB_XSUB(j)  (1280 + 64 * (j))
#define XB_XGEN(j)  (2304 + 64 * (j))
#define XB_TOP      3328
#define XB_TOPGEN   3392
#define XCD_BAR_WORDS 3456
#define XB_SPIN_CAP (1u << 22)
__device__ __forceinline__ unsigned xb_ld(unsigned* p)              { return __hip_atomic_load(p, __ATOMIC_RELAXED, __HIP_MEMORY_SCOPE_AGENT); }
__device__ __forceinline__ unsigned xb_add(unsigned* p, unsigned v) { return __hip_atomic_fetch_add(p, v, __ATOMIC_RELAXED, __HIP_MEMORY_SCOPE_AGENT); }
__device__ __forceinline__ unsigned xb_xcc_id() { return (unsigned)__builtin_amdgcn_s_getreg((3 << 11) | 20) & 0xFu; }
#define XB_SPIN(cond, bar) do { unsigned _sp = 0; while (cond) { __builtin_amdgcn_s_sleep(1); \
    if ((++_sp & 255u) == 0u) { if (xb_ld(&(bar)[XB_TMO])) break; if (_sp > XB_SPIN_CAP) { atomicAdd(&(bar)[XB_TMO], 1u); break; } } } } while (0)
struct XcdBarrier { unsigned* bar; unsigned x; volatile LAS unsigned* st; };
__device__ __forceinline__ XcdBarrier xcd_barrier_post(unsigned* bar, volatile LAS unsigned* st) {
    XcdBarrier b; b.bar = bar; b.x = xb_xcc_id(); b.st = st;
    if (threadIdx.x == 0) (void)xb_add(&bar[XB_XCNT(b.x)], 1u);
    return b;
}
__device__ __forceinline__ void xcd_barrier_complete(unsigned* bar, unsigned x, unsigned& nloc, unsigned& nx) {
    const unsigned G = gridDim.x * gridDim.y * gridDim.z;
    unsigned sum, cnt, mine, sp = 0u;
    for (;;) {
        sum = 0u; cnt = 0u; mine = 0u;
#pragma unroll
        for (unsigned j = 0; j < 16; ++j) { const unsigned c = xb_ld(&bar[XB_XCNT(j)]); sum += c; cnt += (c > 0u) ? 1u : 0u; mine = (j == x) ? c : mine; }
        if (sum == G) break;
        __builtin_amdgcn_s_sleep(1);
        if ((++sp & 255u) == 0u) { if (xb_ld(&bar[XB_TMO])) break; if (sp > XB_SPIN_CAP) { atomicAdd(&bar[XB_TMO], 1u); break; } }
    }
    nloc = mine > 0u ? mine : 1u; nx = cnt > 0u ? cnt : 1u;
}
__device__ __forceinline__ void xcd_barrier(const XcdBarrier& b) {
    asm volatile("s_waitcnt vmcnt(0)" ::: "memory");
    __syncthreads();
    if (threadIdx.x == 0) {
        unsigned* bar = b.bar;
        __builtin_amdgcn_s_waitcnt(0);
        unsigned nloc = b.st[0], nx = b.st[1];
        if (nloc == 0u) { xcd_barrier_complete(bar, b.x, nloc, nx); b.st[0] = nloc; b.st[1] = nx; }
        const unsigned old = xb_add(&bar[XB_XSUB(b.x)], 1u);
        const unsigned gen = old / nloc;
        if (old + 1u == (gen + 1u) * nloc) {
            __builtin_amdgcn_fence(__ATOMIC_RELEASE, "agent");
            asm volatile("s_waitcnt vmcnt(0)" ::: "memory");
            const unsigned og = xb_add(&bar[XB_TOP], 1u);
            const unsigned tg = og / nx;
            if (og + 1u == (tg + 1u) * nx) xb_add(&bar[XB_TOPGEN], 1u);
            else XB_SPIN(xb_ld(&bar[XB_TOPGEN]) == tg, bar);
            __builtin_amdgcn_fence(__ATOMIC_ACQUIRE, "agent");
            xb_add(&bar[XB_XGEN(b.x)], 1u);
            asm volatile("s_waitcnt vmcnt(0)" ::: "memory");
        } else {
            XB_SPIN(xb_ld(&bar[XB_XGEN(b.x)]) == gen, bar);
            __builtin_amdgcn_fence(__ATOMIC_ACQUIRE, "agent");
            asm volatile("s_waitcnt vmcnt(0)" ::: "memory");
        }
    }
    __syncthreads();
}

struct Args { const float* in[24]; float* out; unsigned char* ws; int ph_lo, ph_hi; };
enum { I_X = 0, I_ATTN_NORM, I_W_IN, I_CONV_W, I_CONV_B, I_A_LOG, I_DT_BIAS, I_D_SKIP, I_SSM_NORM, I_NA_RPB, I_MLA_QN, I_MLA_KVN, I_W_UQ, I_W_UKV, I_W_O, I_FFN_NORM,
       I_FFN_G, I_FFN_U, I_FFN_D, I_ROUTER, I_EXP_G, I_EXP_U, I_EXP_D, I_FINAL_NORM };

struct Ctx { LAS unsigned char* lds; int tid, lane, wave, G, bx, vcu; };


__device__ __forceinline__ int inproj_dest(int n) {
    if (n < 512) return C_Z + n;
    if (n < 1536) return C_XBC + (n - 512);
    if (n < 1552) return C_DT + (n - 1536);
    if (n < 2064) return C_NAQ + (n - 1552);
    if (n < 2576) return C_NAK + (n - 2064);
    if (n < 3088) return C_NAV + (n - 2576);
    if (n < 3600) return C_CQ + (n - 3088);
    if (n < 4112) return C_CKV + (n - 3600);
    if (n < 4144) return C_KR + (n - 4112);
    if (n < 4656) return C_DLQ + (n - 4144);
    if (n < 5168) return C_DLK + (n - 4656);
    return C_DLV + (n - 5168);
}
__device__ __forceinline__ int row_map(int mode, int n, int row_off) {
    if (mode == 1) return inproj_dest(n);
    if (mode == 2) return (n >> 7) * 256 + (n & 127);
    if (mode == 3) return (n >> 7) * 256 + 128 + (n & 127);
    return row_off + n;
}
__device__ __forceinline__ void tr_item(const float* W, int K, int N, bf16_t* WT, int mode, int row_off, LAS float* scr, int item, int lane, const float* gain = nullptr) {
    const int nblk = (N + 63) / 64, kb = item / nblk, nb = item - kb * nblk, k0 = 64 * kb, n0 = 64 * nb;
    const int kq = lane >> 4, n4 = (lane & 15) * 4; const bool nok = (n0 + n4) < N;
    f32x4 v[16];
    const float* src = W + (size_t)(k0 + kq) * N + n0 + n4;
#pragma unroll
    for (int i = 0; i < 16; ++i) v[i] = nok ? *(const f32x4*)(src + (size_t)(4 * i) * N) : (f32x4){0.f, 0.f, 0.f, 0.f};
#pragma unroll
    for (int i = 0; i < 16; ++i) { LAS float* d = scr + (4 * i + kq) * 65 + n4; d[0] = v[i].x; d[1] = v[i].y; d[2] = v[i].z; d[3] = v[i].w; }
    LDS_WAIT(); asm volatile("" ::: "memory");
    const int c = lane & 7;
    f32x4 g0 = (f32x4){1.f, 1.f, 1.f, 1.f}, g1 = g0; if (gain) { g0 = *(const f32x4*)(gain + k0 + 8 * c); g1 = *(const f32x4*)(gain + k0 + 8 * c + 4); }
#pragma unroll
    for (int j = 0; j < 8; ++j) { const int n = (lane >> 3) + 8 * j; const LAS float* s = scr + (8 * c) * 65 + n;
        if (n0 + n < N) {
            u32x4 o; o.x = cvt_pk_bf16(s[0 * 65] * g0.x, s[1 * 65] * g0.y); o.y = cvt_pk_bf16(s[2 * 65] * g0.z, s[3 * 65] * g0.w); o.z = cvt_pk_bf16(s[4 * 65] * g1.x, s[5 * 65] * g1.y); o.w = cvt_pk_bf16(s[6 * 65] * g1.z, s[7 * 65] * g1.w);
            *(u32x4*)(WT + (size_t)row_map(mode, n0 + n, row_off) * K + k0 + 8 * c) = o; } }
    LDS_WAIT(); asm volatile("" ::: "memory");
}
__device__ __forceinline__ void tr_item_f8(const float* W, int K, int N, unsigned char* WT, int mode, float scale, LAS float* scr, int item, int lane) {
    const int nblk = (N + 63) / 64, kb = item / nblk, nb = item - kb * nblk, k0 = 64 * kb, n0 = 64 * nb;
    const int kq = lane >> 4, n4 = (lane & 15) * 4; const bool nok = (n0 + n4) < N;
    f32x4 v[16];
    const float* src = W + (size_t)(k0 + kq) * N + n0 + n4;
#pragma unroll
    for (int i = 0; i < 16; ++i) v[i] = nok ? *(const f32x4*)(src + (size_t)(4 * i) * N) : (f32x4){0.f, 0.f, 0.f, 0.f};
#pragma unroll
    for (int i = 0; i < 16; ++i) { LAS float* d = scr + (4 * i + kq) * 65 + n4; d[0] = v[i].x; d[1] = v[i].y; d[2] = v[i].z; d[3] = v[i].w; }
    LDS_WAIT(); asm volatile("" ::: "memory");
    const int c = lane & 7;
#pragma unroll
    for (int j = 0; j < 8; ++j) { const int n = (lane >> 3) + 8 * j; const LAS float* s = scr + (8 * c) * 65 + n;
        if (n0 + n < N) {
            const unsigned w0 = pg8::pk_fp8x4(s[0 * 65] * scale, s[1 * 65] * scale, s[2 * 65] * scale, s[3 * 65] * scale), w1 = pg8::pk_fp8x4(s[4 * 65] * scale, s[5 * 65] * scale, s[6 * 65] * scale, s[7 * 65] * scale);
            *(u32x2*)(WT + (size_t)row_map(mode, n0 + n, 0) * K + k0 + 8 * c) = (u32x2){w0, w1}; } }
    LDS_WAIT(); asm volatile("" ::: "memory");
}
struct ConvJob { const float* W; unsigned char* WT; const float* gain; int K, N, mode, row_off, f8, item, kb, nb; };
constexpr int CI_O = 32 * 64, CI_G = 32 * 176, CI_IN = 32 * 178, CI_UQ = 8 * 24, CI_UKV = 8 * 32;
#ifndef CONV_EXP0
#define CONV_EXP0 4
#endif
constexpr int CONV_N0 = 2 * CI_O + 3 * CI_G + CI_IN + CI_UQ + CI_UKV + CONV_EXP0 * 3 * CI_G, CONV_N1 = (8 - CONV_EXP0) * 3 * CI_G;
#define CJ_KN(NN) { constexpr int nbk_ = ((NN) + 31) >> 5; j.kb = r / nbk_; j.nb = r - j.kb * nbk_; }
__device__ __forceinline__ bool conv_decode(const Args& a, int list, int it, ConvJob& j) {
    unsigned char* ws = a.ws; int r = it; j.f8 = 0; j.row_off = 0; j.mode = 0; j.gain = nullptr;
    if (list == 0) {
        if (r >= CONV_N0) return false;
        if (r < CI_O) { j.W = a.in[I_W_O]; j.WT = ws + WS_WO; j.K = D; j.N = D; j.item = r; CJ_KN(D) return true; } r -= CI_O;
#ifdef DENSE_F8
        constexpr int DF8 = 1, DF8D = 1;
#elif defined(DENSE_DOWN_F8)
        constexpr int DF8 = 0, DF8D = 1;
#else
        constexpr int DF8 = 0, DF8D = 0;
#endif
        if (r < CI_G) { j.W = a.in[I_FFN_G]; j.WT = ws + WS_WGU; j.K = D; j.N = FF; j.mode = 2; j.f8 = DF8; j.item = r; CJ_KN(FF) j.gain = NORM_FOLD ? a.in[I_FFN_NORM] : nullptr; return true; } r -= CI_G;
        if (r < CI_G) { j.W = a.in[I_FFN_U]; j.WT = ws + WS_WGU; j.K = D; j.N = FF; j.mode = 3; j.f8 = DF8; j.item = r; CJ_KN(FF) j.gain = NORM_FOLD ? a.in[I_FFN_NORM] : nullptr; return true; } r -= CI_G;
        if (r < CI_G) { j.W = a.in[I_FFN_D]; j.WT = ws + WS_WDN; j.K = FF; j.N = D; j.f8 = DF8D; j.item = r; CJ_KN(D) return true; } r -= CI_G;
        if (r < CI_IN) { j.W = a.in[I_W_IN] + (size_t)D * DIN; j.WT = ws + WS_WIN + SZ_WIN; j.K = D; j.N = DIN; j.mode = 1; j.item = r; CJ_KN(DIN) j.gain = NORM_FOLD ? a.in[I_ATTN_NORM] + D : nullptr; return true; } r -= CI_IN;
        if (r < CI_O) { j.W = a.in[I_W_O] + (size_t)D * D; j.WT = ws + WS_WO + SZ_WO; j.K = D; j.N = D; j.item = r; CJ_KN(D) return true; } r -= CI_O;
        if (r < CI_UQ) { j.W = a.in[I_W_UQ] + (size_t)512 * 768; j.WT = ws + WS_WUQKV + SZ_WUQKV; j.K = 512; j.N = 768; j.item = r; CJ_KN(768) j.gain = NORM_FOLD ? a.in[I_MLA_QN] + 512 : nullptr; return true; } r -= CI_UQ;
        if (r < CI_UKV) { j.W = a.in[I_W_UKV] + (size_t)512 * 1024; j.WT = ws + WS_WUQKV + SZ_WUQKV; j.K = 512; j.N = 1024; j.row_off = 768; j.item = r; CJ_KN(1024) j.gain = NORM_FOLD ? a.in[I_MLA_KVN] + 512 : nullptr; return true; } r -= CI_UKV;
    } else { if (r >= CONV_N1) return false; }
    const int e = (list ? CONV_EXP0 : 0) + r / (3 * CI_G); r -= (r / (3 * CI_G)) * (3 * CI_G); j.f8 = 1;
    if (r < CI_G) { j.W = a.in[I_EXP_G] + (size_t)e * D * FF; j.WT = ws + WS_WEGU + e * SZ_WGU8; j.K = D; j.N = FF; j.mode = 2; j.item = r; CJ_KN(FF) return true; } r -= CI_G;
    if (r < CI_G) { j.W = a.in[I_EXP_U] + (size_t)e * D * FF; j.WT = ws + WS_WEGU + e * SZ_WGU8; j.K = D; j.N = FF; j.mode = 3; j.item = r; CJ_KN(FF) return true; } r -= CI_G;
    j.W = a.in[I_EXP_D] + (size_t)e * FF * D; j.WT = ws + WS_WEDN + e * SZ_WDN8; j.K = FF; j.N = D; j.item = r; CJ_KN(D) return true;
}
#undef CJ_KN
__device__ __forceinline__ void conv_issue(const ConvJob& j, f32x4 (&v)[8], int lane) {
    const int k0 = 64 * j.kb, n0 = 32 * j.nb;
    const int n4 = (lane & 7) * 4; const bool nok = (n0 + n4) < j.N;
    const float* src = j.W + (size_t)(k0 + 8 * (lane >> 3)) * j.N + n0 + n4;
#pragma unroll
    for (int i = 0; i < 8; ++i) v[i] = nok ? __builtin_nontemporal_load((const f32x4*)(src + (size_t)i * j.N)) : (f32x4){0.f, 0.f, 0.f, 0.f};
}
__device__ __forceinline__ void conv_finish(const ConvJob& j, const f32x4 (&v)[8], LAS float*  , int lane) {
    const int k0 = 64 * j.kb + 8 * (lane >> 3), n0 = 32 * j.nb + (lane & 7) * 4;
    if (n0 < j.N) {
        f32x4 g0 = (f32x4){1.f, 1.f, 1.f, 1.f}, g1 = g0;
        if (j.gain) { g0 = *(const f32x4*)(j.gain + k0); g1 = *(const f32x4*)(j.gain + k0 + 4); }
#pragma unroll
        for (int c = 0; c < 4; ++c) { const size_t row = (size_t)row_map(j.mode, n0 + c, j.row_off);
            const float x0 = v[0][c] * g0.x, x1 = v[1][c] * g0.y, x2 = v[2][c] * g0.z, x3 = v[3][c] * g0.w, x4 = v[4][c] * g1.x, x5 = v[5][c] * g1.y, x6 = v[6][c] * g1.z, x7 = v[7][c] * g1.w;
            if (j.f8) { const unsigned w0 = pg8::pk_fp8x4(x0 * WSCALE8, x1 * WSCALE8, x2 * WSCALE8, x3 * WSCALE8), w1 = pg8::pk_fp8x4(x4 * WSCALE8, x5 * WSCALE8, x6 * WSCALE8, x7 * WSCALE8);
                *(u32x2*)(j.WT + row * j.K + k0) = (u32x2){w0, w1}; }
            else { u32x4 o; o.x = cvt_pk_bf16(x0, x1); o.y = cvt_pk_bf16(x2, x3); o.z = cvt_pk_bf16(x4, x5); o.w = cvt_pk_bf16(x6, x7);
                *(u32x4*)((bf16_t*)j.WT + row * j.K + k0) = o; } }
    }
}
__device__ __forceinline__ void p0_convert(const Ctx& F, const Args& a) {
    LAS float* scr = (LAS float*)(F.lds + F.wave * 16640);
    const int gw = F.vcu * 8 + F.wave, NGW = F.G * 8;
    unsigned char* ws = a.ws;
    constexpr int I_IN = 32 * 89, I_UQ = 8 * 12, I_UKV = 8 * 16;
    constexpr int NITEMS = I_IN + I_UQ + I_UKV;
    for (int it = gw; it < NITEMS; it += NGW) {
        int r = it;
        if (r < I_IN) { tr_item(a.in[I_W_IN], D, DIN, (bf16_t*)(ws + WS_WIN), 1, 0, scr, r, F.lane, NORM_FOLD ? a.in[I_ATTN_NORM] : nullptr); continue; } r -= I_IN;
        if (r < I_UQ) { tr_item(a.in[I_W_UQ], 512, 768, (bf16_t*)(ws + WS_WUQKV), 0, 0, scr, r, F.lane, NORM_FOLD ? a.in[I_MLA_QN] : nullptr); continue; } r -= I_UQ;
        tr_item(a.in[I_W_UKV], 512, 1024, (bf16_t*)(ws + WS_WUQKV), 0, 768, scr, r, F.lane, NORM_FOLD ? a.in[I_MLA_KVN] : nullptr);
    }
    { const int gt = F.vcu * 512 + F.tid, NGT = F.G * 512; constexpr int PADV = (DINP - DIN) * D * 2 / 16;
      for (int i = gt; i < 2 * PADV; i += NGT) { const int l = i / PADV, j = i - l * PADV; ((u32x4*)(ws + WS_WIN + l * SZ_WIN + (size_t)DIN * D * 2))[j] = (u32x4){0u, 0u, 0u, 0u}; } }
    { const int gt = F.vcu * 512 + F.tid, NGT = F.G * 512;
      for (int i = gt; i < T * 32; i += NGT) { const int t = i >> 5, f = i & 31; const float inv = exp2f(-(float)f * (13.287712379549449f / 32.0f)); const float ang = (float)t * inv;
          ((f32x2*)(ws + WS_ROPE))[i] = (f32x2){cosf(ang), sinf(ang)}; } }
}

__device__ __forceinline__ void rms_load(const float* xrow, const bf16_t* y0row, f32x4 (&v)[8], float& rstd, int lane) {
    float ss = 0.f;
#pragma unroll
    for (int j = 0; j < 8; ++j) { v[j] = ((const f32x4*)xrow)[lane + 64 * j]; if (y0row) { const u32x2 yy = ((const u32x2*)y0row)[lane + 64 * j]; v[j] += (f32x4){bf_lo(yy.x), bf_hi(yy.x), bf_lo(yy.y), bf_hi(yy.y)}; } ss += (v[j].x * v[j].x + v[j].y * v[j].y) + (v[j].z * v[j].z + v[j].w * v[j].w); }
    ss = wave_sum(ss);
    rstd = 1.0f / sqrtf(ss * (1.0f / D) + NORM_EPS);
}
__device__ __forceinline__ void rms_load(const bf16_t* xrow, const bf16_t* y0row, f32x4 (&v)[8], float& rstd, int lane) {
    float ss = 0.f;
#pragma unroll
    for (int j = 0; j < 8; ++j) { const u32x2 xx = ((const u32x2*)xrow)[lane + 64 * j]; v[j] = (f32x4){bf_lo(xx.x), bf_hi(xx.x), bf_lo(xx.y), bf_hi(xx.y)};
        if (y0row) { const unsigned y8 = ((const unsigned*)y0row)[lane + 64 * j];
            const auto ylo = __builtin_amdgcn_cvt_pk_f32_fp8((int)y8, false), yhi = __builtin_amdgcn_cvt_pk_f32_fp8((int)y8, true);
            v[j] += (f32x4){ylo[0], ylo[1], yhi[0], yhi[1]} * (1.0f / Y0SCALE); } ss += (v[j].x * v[j].x + v[j].y * v[j].y) + (v[j].z * v[j].z + v[j].w * v[j].w); }
    ss = wave_sum(ss);
    rstd = 1.0f / sqrtf(ss * (1.0f / D) + NORM_EPS);
}
template <class XT>
__device__ __forceinline__ void phase_rowstats(const Ctx& F, const XT* x, float* rstd_out) {
    const int gw = F.vcu * 8 + F.wave, NGW = F.G * 8;
    for (int m = gw; m < M; m += NGW) { f32x4 v[8]; float rstd; rms_load(x + (size_t)m * D, nullptr, v, rstd, F.lane); if (F.lane == 0) rstd_out[m] = rstd; }
}
__device__ __forceinline__ void phase_x_bf16_stats(const Ctx& F, const float* x, bf16_t* xb, float* rstd_out) {
    const int gw = F.vcu * 8 + F.wave, NGW = F.G * 8;
    for (int m = gw; m < M; m += NGW) { f32x4 v[8]; float rstd; rms_load(x + (size_t)m * D, nullptr, v, rstd, F.lane);
        u32x2* o = (u32x2*)(xb + (size_t)m * D);
#pragma unroll
        for (int j = 0; j < 8; ++j) o[F.lane + 64 * j] = (u32x2){cvt_pk_bf16(v[j].x, v[j].y), cvt_pk_bf16(v[j].z, v[j].w)};
        if (F.lane == 0) rstd_out[m] = rstd; }
}
template <class XT>
__device__ __forceinline__ void phase_rmsnorm_bf16(const Ctx& F, const XT* x, const float* w, bf16_t* out) {
    const int gw = F.vcu * 8 + F.wave, NGW = F.G * 8;
    for (int m = gw; m < M; m += NGW) {
        f32x4 v[8]; float rstd; rms_load(x + (size_t)m * D, nullptr, v, rstd, F.lane);
        u32x2* o = (u32x2*)(out + (size_t)m * D);
#pragma unroll
        for (int j = 0; j < 8; ++j) { const f32x4 wv = ((const f32x4*)w)[F.lane + 64 * j]; const f32x4 y = v[j] * rstd * wv; o[F.lane + 64 * j] = (u32x2){cvt_pk_bf16(y.x, y.y), cvt_pk_bf16(y.z, y.w)}; }
    }
}
template <class XT>
__device__ __forceinline__ void phase_rmsnorm_f8(const Ctx& F, const XT* x, const float* w, unsigned char* out) {
    const int gw = F.vcu * 8 + F.wave, NGW = F.G * 8;
    for (int m = gw; m < M; m += NGW) {
        f32x4 v[8]; float rstd; rms_load(x + (size_t)m * D, nullptr, v, rstd, F.lane);
        unsigned* o = (unsigned*)(out + (size_t)m * D);
#pragma unroll
        for (int j = 0; j < 8; ++j) { const f32x4 wv = ((const f32x4*)w)[F.lane + 64 * j]; const f32x4 y = v[j] * rstd * wv; o[F.lane + 64 * j] = pg8::pk_fp8x4(y.x, y.y, y.z, y.w); }
    }
}
template <class XT>
__device__ __forceinline__ void phase_final_norm(const Ctx& F, const XT* x, const bf16_t* y0, const float* w, float* out) {
    const int gw = F.vcu * 8 + F.wave, NGW = F.G * 8;
    for (int m = gw; m < M; m += NGW) {
        f32x4 v[8]; float rstd; rms_load(x + (size_t)m * D, (const bf16_t*)((const unsigned char*)y0 + (size_t)m * D), v, rstd, F.lane);
        f32x4* o = (f32x4*)(out + (size_t)m * D);
#pragma unroll
        for (int j = 0; j < 8; ++j) { const f32x4 wv = ((const f32x4*)w)[F.lane + 64 * j]; o[F.lane + 64 * j] = v[j] * rstd * wv; }
    }
}
template <class XT>
__device__ __forceinline__ void phase_rmsnorm_router(const Ctx& F, const XT* x, const float* w, const float* router  , bf16_t* out, unsigned char* ws) {
    LAS int* hist = (LAS int*)(F.lds);
    if (F.tid < 8) hist[F.tid] = 0;
    __syncthreads();
    const int rows_per_wg = M / F.G;
    for (int i = F.wave; i < rows_per_wg; i += 8) {
        const int m = F.bx * rows_per_wg + i;
        f32x4 v[8]; float rstd; rms_load(x + (size_t)m * D, nullptr, v, rstd, F.lane);
        unsigned* o = (unsigned*)((unsigned char*)out + (size_t)m * D);
        float lg[8];
#pragma unroll
        for (int e = 0; e < 8; ++e) lg[e] = 0.f;
#pragma unroll
        for (int j = 0; j < 8; ++j) { const f32x4 wv = ((const f32x4*)w)[F.lane + 64 * j]; const f32x4 y = v[j] * rstd * wv; o[F.lane + 64 * j] = pg8::pk_fp8x4(y.x, y.y, y.z, y.w);
            const float* rw = router + (size_t)(4 * (F.lane + 64 * j)) * 8;
#pragma unroll
            for (int q = 0; q < 4; ++q) { const f32x4 r0 = ((const f32x4*)(rw + q * 8))[0], r1 = ((const f32x4*)(rw + q * 8))[1]; const float yy = y[q];
                lg[0] += yy * r0.x; lg[1] += yy * r0.y; lg[2] += yy * r0.z; lg[3] += yy * r0.w; lg[4] += yy * r1.x; lg[5] += yy * r1.y; lg[6] += yy * r1.z; lg[7] += yy * r1.w; } }
#pragma unroll
        for (int e = 0; e < 8; ++e) lg[e] = wave_sum(lg[e]);
        int e0 = 0; float v0 = lg[0];
#pragma unroll
        for (int e = 1; e < 8; ++e) if (lg[e] > v0) { v0 = lg[e]; e0 = e; }
        int e1 = -1; float v1 = -3.0e38f;
#pragma unroll
        for (int e = 0; e < 8; ++e) if (e != e0 && lg[e] > v1) { v1 = lg[e]; e1 = e; }
        const float g0 = 1.0f / (1.0f + __expf(v1 - v0)), g1 = 1.0f - g0;
        if (F.lane == 0) { ((u32x4*)(ws + WS_ROUTE))[m] = (u32x4){(unsigned)e0, (unsigned)e1, __float_as_uint(g0), __float_as_uint(g1)}; atomicAdd((int*)hist + e0, 1); atomicAdd((int*)hist + e1, 1); }
    }
    if (F.bx == 0) ((unsigned*)((unsigned char*)out + (size_t)M * D))[F.tid] = 0u;
    __syncthreads();
    if (F.tid < 8) ((int*)(ws + WS_HISTO))[F.bx * 8 + F.tid] = hist[F.tid];
    __syncthreads();
}

__device__ __forceinline__ void phase_token_local(const Ctx& F, const Args& a, int l, const bool dummy = false) {
    unsigned char* ws = a.ws;
    bf16_t* proj = (bf16_t*)(ws + AR_PROJ); bf16_t* xbc = (bf16_t*)(ws + AR_XBC); float* dtb = (float*)(ws + AR_DT);
    const float* cw = a.in[I_CONV_W] + (size_t)l * 5 * 1024; const float* cb = a.in[I_CONV_B] + (size_t)l * 1024;
    const float* dt_bias = a.in[I_DT_BIAS] + l * 16;
    const float* qnw = a.in[I_MLA_QN] + l * 512; const float* kvnw = a.in[I_MLA_KVN] + l * 512;
    const f32x2* rope = (const f32x2*)(ws + WS_ROPE);
    const int gw = F.vcu * 8 + F.wave, NGW = F.G * 8, lane = F.lane;
    float cwr[5][16], cbr[16];
#pragma unroll
    for (int j = 0; j < 4; ++j) { const f32x4 b4 = ((const f32x4*)cb)[4 * lane + j]; cbr[4 * j] = b4.x; cbr[4 * j + 1] = b4.y; cbr[4 * j + 2] = b4.z; cbr[4 * j + 3] = b4.w; }
#pragma unroll
    for (int k = 0; k < 5; ++k)
#pragma unroll
        for (int j = 0; j < 4; ++j) { const f32x4 w4 = ((const f32x4*)(cw + k * 1024 + 16 * lane))[j]; cwr[k][4 * j] = w4.x; cwr[k][4 * j + 1] = w4.y; cwr[k][4 * j + 2] = w4.z; cwr[k][4 * j + 3] = w4.w; }
    for (int mc = gw * 8; mc < M; mc += NGW * 8) {
    u32x4 win[5][2];
#pragma unroll
    for (int k = 0; k < 4; ++k) { const int tt = (mc & (T - 1)) + k - 2; const bool ok = tt >= 0 && tt < T; const u32x4* src = (const u32x4*)(proj + (size_t)(mc + k - 2) * DINP + C_XBC + 16 * lane);
        win[k + 1][0] = ok ? src[0] : (u32x4){0u, 0u, 0u, 0u}; win[k + 1][1] = ok ? src[1] : (u32x4){0u, 0u, 0u, 0u}; }
#pragma unroll 1
    for (int mi = 0; mi < 8; ++mi) {
        const int m = mc + mi;
        const int t = m & (T - 1);
        bf16_t* prow = proj + (size_t)m * DINP;
        bf16_t* wrow = dummy ? (bf16_t*)(ws + AR_ST) + (size_t)m * 3072 - C_CQ : prow;
        {
#pragma unroll
            for (int k = 0; k < 4; ++k) { win[k][0] = win[k + 1][0]; win[k][1] = win[k + 1][1]; }
            { const int tt = t + 2; const bool ok = tt < T; const u32x4* src = (const u32x4*)(prow + (ptrdiff_t)2 * DINP + C_XBC + 16 * lane);
              win[4][0] = ok ? src[0] : (u32x4){0u, 0u, 0u, 0u}; win[4][1] = ok ? src[1] : (u32x4){0u, 0u, 0u, 0u}; }
            float acc[16];
#pragma unroll
            for (int j = 0; j < 16; ++j) acc[j] = cbr[j];
#pragma unroll
            for (int k = 0; k < 5; ++k) { const unsigned xs[8] = {win[k][0].x, win[k][0].y, win[k][0].z, win[k][0].w, win[k][1].x, win[k][1].y, win[k][1].z, win[k][1].w};
#pragma unroll
                for (int j = 0; j < 8; ++j) { acc[2 * j] += cwr[k][2 * j] * bf_lo(xs[j]); acc[2 * j + 1] += cwr[k][2 * j + 1] * bf_hi(xs[j]); } }
            u32x4 o0, o1;
            o0.x = cvt_pk_bf16(silu_f(acc[0]), silu_f(acc[1])); o0.y = cvt_pk_bf16(silu_f(acc[2]), silu_f(acc[3])); o0.z = cvt_pk_bf16(silu_f(acc[4]), silu_f(acc[5])); o0.w = cvt_pk_bf16(silu_f(acc[6]), silu_f(acc[7]));
            o1.x = cvt_pk_bf16(silu_f(acc[8]), silu_f(acc[9])); o1.y = cvt_pk_bf16(silu_f(acc[10]), silu_f(acc[11])); o1.z = cvt_pk_bf16(silu_f(acc[12]), silu_f(acc[13])); o1.w = cvt_pk_bf16(silu_f(acc[14]), silu_f(acc[15]));
            u32x4* dst = (u32x4*)(xbc + (size_t)m * 1024 + 16 * lane); dst[0] = o0; dst[1] = o1;
        }
        if (lane < 16) { const float v = bf2f(prow[C_DT + lane]) + dt_bias[lane]; dtb[(size_t)m * 16 + lane] = v > 20.f ? v : log1pf(__expf(v)); }
        {
            const int hh = lane >> 2, qq = lane & 3;
            u32x4* p1 = (u32x4*)(prow + C_DLQ + hh * 64 + 8 * qq); u32x4* p2 = (u32x4*)(prow + C_DLQ + hh * 64 + 32 + 8 * qq);
            const u32x4 a1 = *p1, a2 = *p2;
            const f32x4* cs4 = (const f32x4*)(rope + (size_t)t * 32 + 8 * qq);
            const unsigned x1[4] = {a1.x, a1.y, a1.z, a1.w}, x2[4] = {a2.x, a2.y, a2.z, a2.w}; unsigned o1[4], o2[4];
#pragma unroll
            for (int j = 0; j < 4; ++j) { const f32x4 c = cs4[j];
                const float u0 = bf_lo(x1[j]), u1 = bf_hi(x1[j]), w0 = bf_lo(x2[j]), w1 = bf_hi(x2[j]);
                o1[j] = cvt_pk_bf16(u0 * c.x - w0 * c.y, u1 * c.z - w1 * c.w); o2[j] = cvt_pk_bf16(w0 * c.x + u0 * c.y, w1 * c.z + u1 * c.w); }
            *(u32x4*)(wrow + ((bf16_t*)p1 - prow)) = (u32x4){o1[0], o1[1], o1[2], o1[3]}; *(u32x4*)(wrow + ((bf16_t*)p2 - prow)) = (u32x4){o2[0], o2[1], o2[2], o2[3]};
        }
        if (lane < 2) {
            u32x4* p1 = (u32x4*)(prow + C_KR + 8 * lane); u32x4* p2 = (u32x4*)(prow + C_KR + 16 + 8 * lane);
            const u32x4 a1 = *p1, a2 = *p2; const unsigned x1[4] = {a1.x, a1.y, a1.z, a1.w}, x2[4] = {a2.x, a2.y, a2.z, a2.w}; unsigned o1[4], o2[4];
#pragma unroll
            for (int j = 0; j < 4; ++j) { const f32x2 c0 = rope[(size_t)t * 32 + 2 * (8 * lane + 2 * j)], c1 = rope[(size_t)t * 32 + 2 * (8 * lane + 2 * j + 1)];
                const float u0 = bf_lo(x1[j]), u1 = bf_hi(x1[j]), w0 = bf_lo(x2[j]), w1 = bf_hi(x2[j]);
                o1[j] = cvt_pk_bf16(u0 * c0.x - w0 * c0.y, u1 * c1.x - w1 * c1.y); o2[j] = cvt_pk_bf16(w0 * c0.x + u0 * c0.y, w1 * c1.x + u1 * c1.y); }
            *(u32x4*)(wrow + ((bf16_t*)p1 - prow)) = (u32x4){o1[0], o1[1], o1[2], o1[3]}; *(u32x4*)(wrow + ((bf16_t*)p2 - prow)) = (u32x4){o2[0], o2[1], o2[2], o2[3]};
        }
#pragma unroll
        for (int which = 0; which < 2; ++which) {
            u32x4* p = (u32x4*)(prow + (which ? C_CKV : C_CQ) + 8 * lane); const float* nw = (which ? kvnw : qnw) + 8 * lane;
            const u32x4 av = *p; const unsigned xs[4] = {av.x, av.y, av.z, av.w}; float f[8]; float ss = 0.f;
#pragma unroll
            for (int j = 0; j < 4; ++j) { f[2 * j] = bf_lo(xs[j]); f[2 * j + 1] = bf_hi(xs[j]); ss += f[2 * j] * f[2 * j] + f[2 * j + 1] * f[2 * j + 1]; }
            ss = wave_sum(ss); const float rstd = 1.0f / sqrtf(ss * (1.0f / 512.0f) + NORM_EPS);
#if NORM_FOLD
            if (lane == 0 && !dummy) ((float*)(ws + WS_RSTD2))[(size_t)m * 2 + which] = rstd;
            (void)nw;
#else
            const f32x4 w0 = ((const f32x4*)nw)[0], w1 = ((const f32x4*)nw)[1];
            *(u32x4*)(wrow + ((bf16_t*)p - prow)) = (u32x4){cvt_pk_bf16(f[0] * rstd * w0.x, f[1] * rstd * w0.y), cvt_pk_bf16(f[2] * rstd * w0.z, f[3] * rstd * w0.w), cvt_pk_bf16(f[4] * rstd * w1.x, f[5] * rstd * w1.y), cvt_pk_bf16(f[6] * rstd * w1.z, f[7] * rstd * w1.w)};
#endif
        }
    }
    }
}

__device__ __forceinline__ float wave_incl_scan(float v, int lane) {
#pragma unroll
    for (int o = 1; o < 64; o <<= 1) { const float t = __int_as_float(__builtin_amdgcn_ds_bpermute(((lane - o) & 63) << 2, __float_as_int(v))); if (lane >= o) v += t; }
    return v;
}
__device__ __forceinline__ bf16x8 scale8(bf16x8 a, const float* w) {
    u32x4 o;
    o.x = cvt_pk_bf16(bf2f((bf16_t)a[0]) * w[0], bf2f((bf16_t)a[1]) * w[1]); o.y = cvt_pk_bf16(bf2f((bf16_t)a[2]) * w[2], bf2f((bf16_t)a[3]) * w[3]);
    o.z = cvt_pk_bf16(bf2f((bf16_t)a[4]) * w[4], bf2f((bf16_t)a[5]) * w[5]); o.w = cvt_pk_bf16(bf2f((bf16_t)a[6]) * w[6], bf2f((bf16_t)a[7]) * w[7]);
    return __builtin_bit_cast(bf16x8, o);
}
__device__ __forceinline__ void phase_ssm_states(const Ctx& F, const Args& a, int l) {
    unsigned char* ws = a.ws;
    const bf16_t* xbc = (const bf16_t*)(ws + AR_XBC); const float* dtb = (const float*)(ws + AR_DT);
    float* csg = (float*)(ws + AR_CS); float* cdec = (float*)(ws + WS_CDEC); bf16_t* states = (bf16_t*)(ws + AR_ST);
    constexpr int XS_STRIDE = 144, XS_HEAD = 128 * XS_STRIDE, BS_OFF = 4 * XS_HEAD, BS_STRIDE = 272, WT_OFF = BS_OFF + 128 * BS_STRIDE;
    LAS unsigned char* lds = F.lds; LAS float* WT = (LAS float*)(lds + WT_OFF);
    const int lane = F.lane, wave = F.wave, tid = F.tid, hi = lane >> 5, g1 = (lane >> 4) & 1, q4 = (lane & 15) >> 2, p4 = lane & 3;
    for (int u = F.bx; u < NB * 32 * 2; u += F.G) {
        const int b = u >> 6, c = (u >> 1) & 31, g = u & 1; const size_t row0 = (size_t)b * T + c * 128;
#pragma unroll
        for (int i = 0; i < 8; ++i) { const int idx = tid + 512 * i, s = idx >> 5, ch = idx & 31;
            const u32x4 v = *(const u32x4*)(xbc + (row0 + s) * 1024 + 256 * g + 8 * ch); *(LAS u32x4*)(lds + (ch >> 3) * XS_HEAD + s * XS_STRIDE + (ch & 7) * 16) = v; }
#pragma unroll
        for (int i = 0; i < 4; ++i) { const int idx = tid + 512 * i, s = idx >> 4, ch = idx & 15;
            const u32x4 v = *(const u32x4*)(xbc + (row0 + s) * 1024 + 512 + 128 * g + 8 * ch); *(LAS u32x4*)(lds + BS_OFF + s * BS_STRIDE + ch * 16) = v; }
        const int hl = wave & 3, dir = wave >> 2, h = 4 * g + hl;
        {
            const float dt0 = dtb[(row0 + lane) * 16 + dir * 8 + h], dt1 = dtb[(row0 + 64 + lane) * 16 + dir * 8 + h];
            const float A = -__expf(a.in[I_A_LOG][l * 16 + dir * 8 + h]);
            const float da0 = dt0 * A, da1 = dt1 * A;
            float s0 = wave_incl_scan(da0, lane); const float tot0 = __int_as_float(__builtin_amdgcn_readlane(__float_as_int(s0), 63));
            float s1 = wave_incl_scan(da1, lane) + tot0; const float total = __int_as_float(__builtin_amdgcn_readlane(__float_as_int(s1), 63));
            float c0, c1, w0, w1;
            if (dir == 0) { c0 = s0; c1 = s1; w0 = __expf(total - s0) * dt0; w1 = __expf(total - s1) * dt1; }
            else { c0 = total - s0 + da0; c1 = total - s1 + da1; w0 = __expf(total - c0) * dt0; w1 = __expf(total - c1) * dt1; }
            float* cso = csg + ((size_t)(b * 2 + dir) * 8 + h) * T + c * 128;
            cso[lane] = c0; cso[64 + lane] = c1;
            if (lane == 0) cdec[((b * 2 + dir) * 8 + h) * 32 + c] = __expf(total);
            WT[wave * 128 + lane] = w0; WT[wave * 128 + 64 + lane] = w1;
        }
        __syncthreads();
        f32x16 acc[2][4];
#pragma unroll
        for (int pb = 0; pb < 2; ++pb)
#pragma unroll
            for (int nb = 0; nb < 4; ++nb) acc[pb][nb] = f32x16{};
        LAS const char* xs_base = (LAS const char*)lds + hl * XS_HEAD + (8 * hi + q4) * XS_STRIDE + (16 * g1 + 4 * p4) * 2;
        LAS const char* bs_base = (LAS const char*)lds + BS_OFF + (8 * hi + q4) * BS_STRIDE + (16 * g1 + 4 * p4) * 2;
#pragma unroll 1
        for (int ks = 0; ks < 8; ++ks) {
            float wl[8];
            { const f32x4 wa = *(LAS const f32x4*)(WT + wave * 128 + 16 * ks + 8 * hi), wb = *(LAS const f32x4*)(WT + wave * 128 + 16 * ks + 8 * hi + 4);
              wl[0] = wa.x; wl[1] = wa.y; wl[2] = wa.z; wl[3] = wa.w; wl[4] = wb.x; wl[5] = wb.y; wl[6] = wb.z; wl[7] = wb.w; }
            bf16x8 af[2], bfr[4];
#pragma unroll
            for (int pb = 0; pb < 2; ++pb) { const s16x4 lo = trr(xs_base + ks * 16 * XS_STRIDE + pb * 64), hh = trr(xs_base + ks * 16 * XS_STRIDE + 4 * XS_STRIDE + pb * 64); af[pb] = scale8(cat8(lo, hh), wl); }
#pragma unroll
            for (int nb = 0; nb < 4; ++nb) { const s16x4 lo = trr(bs_base + ks * 16 * BS_STRIDE + nb * 64), hh = trr(bs_base + ks * 16 * BS_STRIDE + 4 * BS_STRIDE + nb * 64); bfr[nb] = cat8(lo, hh); }
#pragma unroll
            for (int pb = 0; pb < 2; ++pb)
#pragma unroll
                for (int nb = 0; nb < 4; ++nb) acc[pb][nb] = __builtin_amdgcn_mfma_f32_32x32x16_bf16(af[pb], bfr[nb], acc[pb][nb], 0, 0, 0);
        }
        bf16_t* so = states + ((size_t)((b * 2 + dir) * 8 + h) * 32 + c) * 8192;
        const bool oddl = (lane & 1) != 0;
#pragma unroll
        for (int pb = 0; pb < 2; ++pb)
#pragma unroll
            for (int nb = 0; nb < 4; ++nb)
#pragma unroll
                for (int r = 0; r < 16; r += 2) { const float mine0 = acc[pb][nb][r], mine1 = acc[pb][nb][r + 1];
                    const float got = swz_xor<1>(oddl ? mine0 : mine1);
                    const unsigned w = oddl ? cvt_pk_bf16(got, mine1) : cvt_pk_bf16(mine0, got);
                    *(unsigned*)(so + (32 * pb + crow(r + (oddl ? 1 : 0), hi)) * 128 + 32 * nb + (lane & 31) - (oddl ? 1 : 0)) = w; }
        __syncthreads();
    }
}
__device__ __forceinline__ void phase_ssm_scan(const Ctx& F, const Args& a) {
    unsigned char* ws = a.ws;
    const bf16_t* states = (const bf16_t*)(ws + AR_ST); const float* cdec = (const float*)(ws + WS_CDEC); bf16_t* prev = (bf16_t*)(ws + AR_PREV);
    const int gt = F.vcu * 512 + F.tid, NGT = F.G * 512;
    for (int e4 = gt; e4 < NB * 2 * 8 * 2048; e4 += NGT) {
        const int bdh = e4 >> 11, off = (e4 & 2047) * 4, dir = (bdh >> 3) & 1;
        f32x4 carry = (f32x4){0.f, 0.f, 0.f, 0.f};
#pragma unroll 4
        for (int i = 0; i < 32; ++i) {
            const int c = dir ? 31 - i : i; const size_t o = ((size_t)bdh * 32 + c) * 8192 + off;
            const u32x2 sw = *(const u32x2*)(states + o); const f32x4 S = (f32x4){bf_lo(sw.x), bf_hi(sw.x), bf_lo(sw.y), bf_hi(sw.y)}; const float dec = cdec[bdh * 32 + c];
            *(u32x2*)(prev + o) = (u32x2){cvt_pk_bf16(carry.x, carry.y), cvt_pk_bf16(carry.z, carry.w)};
            carry = carry * dec + S;
        }
    }
}
__device__ __forceinline__ void phase_ssm_out(const Ctx& F, const Args& a, int l) {
    unsigned char* ws = a.ws;
    const bf16_t* xbc = (const bf16_t*)(ws + AR_XBC); const float* dtb = (const float*)(ws + AR_DT); const float* csg = (const float*)(ws + AR_CS);
    const bf16_t* prev = (const bf16_t*)(ws + AR_PREV); const bf16_t* proj = (const bf16_t*)(ws + AR_PROJ); bf16_t* mixed = (bf16_t*)(ws + AR_MIXED);
    constexpr int XS_STRIDE = 144, XS_HEAD = 128 * XS_STRIDE, BS_OFF = 4 * XS_HEAD, BC_STRIDE = 272, CS_OFF = BS_OFF + 128 * BC_STRIDE, TAB_OFF = CS_OFF + 64 * BC_STRIDE, SS_OFF = TAB_OFF + 4 * 2048;
    static_assert(SS_OFF + 2048 <= LDS_MISC, "ssm_out LDS");
    LAS unsigned char* lds = F.lds;
    const int lane = F.lane, tid = F.tid, hl = F.wave & 3, lb = F.wave >> 2, hi = lane >> 5, r32 = lane & 31, g1 = (lane >> 4) & 1, q4 = (lane & 15) >> 2, p4 = lane & 3;
    LAS float* tab = (LAS float*)(lds + TAB_OFF + hl * 2048);
    LAS float* SS = (LAS float*)(lds + SS_OFF);
    for (int u = F.bx; u < NB * 32 * 2; u += F.G) {
        const int b = u >> 6, c = (u >> 1) & 31, hf = u & 1; const size_t row0 = (size_t)b * T + c * 128;
        const int lloc = 64 * hf + 32 * lb + r32;
        unsigned ygp[2][2][8];
#pragma unroll
        for (int g = 0; g < 2; ++g) {
            const int h = 4 * g + hl;
#pragma unroll
            for (int i = 0; i < 8; ++i) { const int idx = tid + 512 * i, s = idx >> 5, ch = idx & 31;
                const u32x4 v = *(const u32x4*)(xbc + (row0 + s) * 1024 + 256 * g + 8 * ch); *(LAS u32x4*)(lds + (ch >> 3) * XS_HEAD + s * XS_STRIDE + (ch & 7) * 16) = v; }
#pragma unroll
            for (int i = 0; i < 4; ++i) { const int idx = tid + 512 * i, s = idx >> 4, ch = idx & 15;
                const u32x4 v = *(const u32x4*)(xbc + (row0 + s) * 1024 + 512 + 128 * g + 8 * ch); *(LAS u32x4*)(lds + BS_OFF + s * BC_STRIDE + ch * 16) = v; }
#pragma unroll
            for (int i = 0; i < 2; ++i) { const int idx = tid + 512 * i, s = idx >> 4, ch = idx & 15;
                const u32x4 v = *(const u32x4*)(xbc + (row0 + 64 * hf + s) * 1024 + 768 + 128 * g + 8 * ch); *(LAS u32x4*)(lds + CS_OFF + s * BC_STRIDE + ch * 16) = v; }
            { const int th = tid >> 7, s = tid & 127, hh_ = 4 * g + th; LAS float* tb = (LAS float*)(lds + TAB_OFF + th * 2048);
              tb[s] = csg[((size_t)(b * 2 + 0) * 8 + hh_) * T + c * 128 + s]; tb[128 + s] = csg[((size_t)(b * 2 + 1) * 8 + hh_) * T + c * 128 + s];
              tb[256 + s] = dtb[(row0 + s) * 16 + hh_]; tb[384 + s] = dtb[(row0 + s) * 16 + 8 + hh_]; }
            __syncthreads();
            const float dskip = a.in[I_D_SKIP][l * 8 + h];
            const float csf_l = tab[lloc], csb_l = tab[128 + lloc];
            LAS const char* cf_base = (LAS const char*)lds + CS_OFF + (32 * lb + r32) * BC_STRIDE + 16 * hi;
#define CF(ks) (*(LAS const bf16x8*)(cf_base + 32 * (ks)))
            f32x16 y[2]; y[0] = f32x16{}; y[1] = f32x16{};
            LAS const char* xs_base = (LAS const char*)lds + hl * XS_HEAD + (4 * hi + q4) * XS_STRIDE + (16 * g1 + 4 * p4) * 2;
#pragma unroll 1
            for (int sb = 0; sb < 4; ++sb) {
                f32x16 gt = f32x16{};
                {
                    bf16x8 Bf[8];
#pragma unroll
                    for (int ks = 0; ks < 8; ++ks) Bf[ks] = *(LAS const bf16x8*)(lds + BS_OFF + (32 * sb + r32) * BC_STRIDE + (16 * ks + 8 * hi) * 2);
#pragma unroll
                    for (int kh = 0; kh < 4; ++kh) { const bf16x8 c0 = CF(2 * kh), c1 = CF(2 * kh + 1);
                        __builtin_amdgcn_sched_barrier(0);
                        gt = __builtin_amdgcn_mfma_f32_32x32x16_bf16(Bf[2 * kh], c0, gt, 0, 0, 0); gt = __builtin_amdgcn_mfma_f32_32x32x16_bf16(Bf[2 * kh + 1], c1, gt, 0, 0, 0); }
                }

                unsigned pw[8];
#pragma unroll
                for (int r2 = 0; r2 < 8; ++r2) { float pv2[2];
#pragma unroll
                    for (int e = 0; e < 2; ++e) { const int r = 2 * r2 + e; const int s = 32 * sb + crow(r, hi);
                        const float ef = __expf(fminf(csf_l - tab[s], 0.f)) * tab[256 + s], eb = __expf(fminf(csb_l - tab[128 + s], 0.f)) * tab[384 + s];
                        const float wsum = (s <= lloc ? ef : 0.f) + (s >= lloc ? eb : 0.f);
                        pv2[e] = gt[r] * wsum + (s == lloc ? dskip : 0.f); }
                    pw[r2] = cvt_pk_bf16(pv2[0], pv2[1]); }
                u32x4 w0, w1;
                w0.x = pw[0]; w0.y = pw[1]; w0.z = pw[2]; w0.w = pw[3]; w1.x = pw[4]; w1.y = pw[5]; w1.z = pw[6]; w1.w = pw[7];
                const bf16x8 pb0 = __builtin_bit_cast(bf16x8, w0), pb1 = __builtin_bit_cast(bf16x8, w1);
#pragma unroll
                for (int pb = 0; pb < 2; ++pb)
#pragma unroll
                    for (int s2 = 0; s2 < 2; ++s2) { LAS const char* p = xs_base + (32 * sb + 16 * s2) * XS_STRIDE + pb * 64;
                        const s16x4 lo = trr(p), hh = trr(p + 8 * XS_STRIDE);
                        y[pb] = __builtin_amdgcn_mfma_f32_32x32x16_bf16(cat8(lo, hh), s2 ? pb1 : pb0, y[pb], 0, 0, 0); }
            }
#pragma unroll
            for (int dir = 0; dir < 2; ++dir) {
                const float el = __expf(dir ? csb_l : csf_l);
                const bf16_t* pv = prev + ((size_t)((b * 2 + dir) * 8 + h) * 32 + c) * 8192;
#pragma unroll
                for (int pb = 0; pb < 2; ++pb) { f32x16 ta = f32x16{};
                    bf16x8 Pf[8];
#pragma unroll
                    for (int ks = 0; ks < 8; ++ks) Pf[ks] = *(const bf16x8*)(pv + (32 * pb + r32) * 128 + 16 * ks + 8 * hi);
                    __builtin_amdgcn_sched_barrier(0);
#pragma unroll
                    for (int ks = 0; ks < 8; ++ks) ta = __builtin_amdgcn_mfma_f32_32x32x16_bf16(Pf[ks], CF(ks), ta, 0, 0, 0);
#pragma unroll
                    for (int r = 0; r < 16; ++r) y[pb][r] += el * ta[r];
                    __builtin_amdgcn_sched_barrier(0); }
            }
            float sq = 0.f;
            const bf16_t* zrow = proj + (row0 + lloc) * DINP + C_Z + h * 64;
#pragma unroll
            for (int pb = 0; pb < 2; ++pb)
#pragma unroll
                for (int g4 = 0; g4 < 4; ++g4) { const u32x2 zz = *(const u32x2*)(zrow + 32 * pb + 8 * g4 + 4 * hi);
                    const float z0 = bf_lo(zz.x), z1 = bf_hi(zz.x), z2 = bf_lo(zz.y), z3 = bf_hi(zz.y);
                    float v0 = y[pb][4 * g4] * silu_f(z0), v1 = y[pb][4 * g4 + 1] * silu_f(z1), v2 = y[pb][4 * g4 + 2] * silu_f(z2), v3 = y[pb][4 * g4 + 3] * silu_f(z3);
                    ygp[g][pb][2 * g4] = cvt_pk_bf16(v0, v1); ygp[g][pb][2 * g4 + 1] = cvt_pk_bf16(v2, v3);
                    sq += (v0 * v0 + v1 * v1) + (v2 * v2 + v3 * v3); }
            sq = xhalf_sum(sq);
#undef CF
            if (hi == 0) SS[h * 64 + 32 * lb + r32] = sq;
            __syncthreads();
        }
        float tot = 0.f;
#pragma unroll
        for (int w = 0; w < 8; ++w) tot += SS[w * 64 + 32 * lb + r32];
        const float rstd = 1.0f / sqrtf(tot * (1.0f / 512.0f) + NORM_EPS);
#pragma unroll
        for (int g = 0; g < 2; ++g) {
            const int h = 4 * g + hl; const float* nw = a.in[I_SSM_NORM] + l * 512 + h * 64;
            bf16_t* orow = mixed + (row0 + lloc) * D + h * 64;
            f32x4 wv[2][4];
#pragma unroll
            for (int pb = 0; pb < 2; ++pb)
#pragma unroll
                for (int g4 = 0; g4 < 4; ++g4) wv[pb][g4] = *(const f32x4*)(nw + 32 * pb + 8 * g4 + 4 * hi);
            asm volatile("" ::: "memory");
#pragma unroll
            for (int pb = 0; pb < 2; ++pb)
#pragma unroll
                for (int g4 = 0; g4 < 4; ++g4) { const int p0 = 32 * pb + 8 * g4 + 4 * hi; const f32x4 w4 = wv[pb][g4];
                    const float v0 = bf_lo(ygp[g][pb][2 * g4]), v1 = bf_hi(ygp[g][pb][2 * g4]), v2 = bf_lo(ygp[g][pb][2 * g4 + 1]), v3 = bf_hi(ygp[g][pb][2 * g4 + 1]);
                    *(u32x2*)(orow + p0) = (u32x2){cvt_pk_bf16(v0 * rstd * w4.x, v1 * rstd * w4.y), cvt_pk_bf16(v2 * rstd * w4.z, v3 * rstd * w4.w)}; }
        }
        __syncthreads();
    }
}
__device__ __forceinline__ void phase_dil_merge(const Ctx& F, const Args& a) {
    unsigned char* ws = a.ws;
    const bf16_t* dilp = (const bf16_t*)(ws + AR_DILP); const float* dlse = (const float*)(ws + AR_DLSE); bf16_t* mixed = (bf16_t*)(ws + AR_MIXED);
    const int gw = F.vcu * 8 + F.wave, NGW = F.G * 8, lane = F.lane, hd = lane >> 3;
    for (int m = gw; m < M; m += NGW) {
        float ls[3]; u32x2 ov[3];
#pragma unroll
        for (int br = 0; br < 3; ++br) { ls[br] = dlse[((size_t)br * M + m) * 8 + hd]; ov[br] = *(const u32x2*)((const unsigned char*)dilp + ((size_t)br * M + m) * 512 + 8 * lane); }
        const float mx = fmaxf(ls[0], fmaxf(ls[1], ls[2]));
        float w[3]; float wsum = 0.f;
#pragma unroll
        for (int br = 0; br < 3; ++br) { w[br] = __expf(ls[br] - mx); wsum += w[br]; }
        const float inv = 1.0f / wsum; float o[8];
#pragma unroll
        for (int j = 0; j < 8; ++j) o[j] = 0.f;
#pragma unroll
        for (int br = 0; br < 3; ++br) { const float wb = w[br] * inv * (1.0f / 16.0f);
            const auto a0 = __builtin_amdgcn_cvt_pk_f32_fp8((int)ov[br].x, false), a1 = __builtin_amdgcn_cvt_pk_f32_fp8((int)ov[br].x, true), a2 = __builtin_amdgcn_cvt_pk_f32_fp8((int)ov[br].y, false), a3 = __builtin_amdgcn_cvt_pk_f32_fp8((int)ov[br].y, true);
            o[0] += wb * a0[0]; o[1] += wb * a0[1]; o[2] += wb * a1[0]; o[3] += wb * a1[1]; o[4] += wb * a2[0]; o[5] += wb * a2[1]; o[6] += wb * a3[0]; o[7] += wb * a3[1]; }
        *(u32x4*)(mixed + (size_t)m * D + 1536 + 8 * lane) = (u32x4){cvt_pk_bf16(o[0], o[1]), cvt_pk_bf16(o[2], o[3]), cvt_pk_bf16(o[4], o[5]), cvt_pk_bf16(o[6], o[7])};
    }
}

struct AttnAcc { f32x16 o[2]; float m, l; };
__device__ __forceinline__ void attn_init(AttnAcc& s) { s.o[0] = f32x16{}; s.o[1] = f32x16{}; s.m = -__builtin_inff(); s.l = 0.f; }
template <int DHS>
__device__ __forceinline__ void attn_block(AttnAcc& st, f32x16& sc, LAS const char* vb, int lane) {
    const int hi = lane >> 5, g1 = (lane >> 4) & 1, q4 = (lane & 15) >> 2, p4 = lane & 3;
    float mx = sc[0];
#pragma unroll
    for (int r = 1; r < 16; ++r) mx = fmaxf(mx, sc[r]);
    mx = xhalf_max(mx);
    const float mn = fmaxf(st.m, mx);
    const float mu = (mn == -__builtin_inff()) ? 0.f : mn;
    const float alpha = __builtin_amdgcn_exp2f(st.m - mu);
    float sum = 0.f;
#pragma unroll
    for (int r = 0; r < 16; ++r) { sc[r] = __builtin_amdgcn_exp2f(sc[r] - mu); sum += sc[r]; }
    st.l = st.l * alpha + sum; st.m = mn;
    if (__builtin_amdgcn_ballot_w64(alpha != 1.0f) != 0ull) {
#pragma unroll
        for (int d0 = 0; d0 < 2; ++d0)
#pragma unroll
            for (int r = 0; r < 16; ++r) st.o[d0][r] *= alpha;
    }
    u32x4 w0, w1;
    w0.x = cvt_pk_bf16(sc[0], sc[1]); w0.y = cvt_pk_bf16(sc[2], sc[3]); w0.z = cvt_pk_bf16(sc[4], sc[5]); w0.w = cvt_pk_bf16(sc[6], sc[7]);
    w1.x = cvt_pk_bf16(sc[8], sc[9]); w1.y = cvt_pk_bf16(sc[10], sc[11]); w1.z = cvt_pk_bf16(sc[12], sc[13]); w1.w = cvt_pk_bf16(sc[14], sc[15]);
    const bf16x8 pb0 = __builtin_bit_cast(bf16x8, w0), pb1 = __builtin_bit_cast(bf16x8, w1);
    LAS const char* base = vb + (4 * hi + q4) * 64 + g1 * 32 + p4 * 8;
#pragma unroll
    for (int d0 = 0; d0 < 2; ++d0)
#pragma unroll
        for (int s2 = 0; s2 < 2; ++s2) { LAS const char* p = base + d0 * DHS + s2 * 1024; const s16x4 lo = trr(p), hh = trr(p + 512);
            st.o[d0] = __builtin_amdgcn_mfma_f32_32x32x16_bf16(cat8(lo, hh), s2 ? pb1 : pb0, st.o[d0], 0, 0, 0); }
}
__device__ __forceinline__ float attn_store(const AttnAcc& st, bf16_t* orow, int lane) {
    const int hi = lane >> 5; const float lt = xhalf_sum(st.l); const float inv = 1.0f / lt;
#pragma unroll
    for (int d0 = 0; d0 < 2; ++d0)
#pragma unroll
        for (int g4 = 0; g4 < 4; ++g4)
            *(u32x2*)(orow + 32 * d0 + 8 * g4 + 4 * hi) = (u32x2){cvt_pk_bf16(st.o[d0][4 * g4] * inv, st.o[d0][4 * g4 + 1] * inv), cvt_pk_bf16(st.o[d0][4 * g4 + 2] * inv, st.o[d0][4 * g4 + 3] * inv)};
    return lt;
}
constexpr float DSCALE = 16.0f;
__device__ __forceinline__ float attn_store_f8(const AttnAcc& st, unsigned char* orow, int lane) {
    const int hi = lane >> 5; const float lt = xhalf_sum(st.l); const float inv = DSCALE / lt;
#pragma unroll
    for (int d0 = 0; d0 < 2; ++d0)
#pragma unroll
        for (int g4 = 0; g4 < 4; ++g4)
            *(unsigned*)(orow + 32 * d0 + 8 * g4 + 4 * hi) = pg8::pk_fp8x4(st.o[d0][4 * g4] * inv, st.o[d0][4 * g4 + 1] * inv, st.o[d0][4 * g4 + 2] * inv, st.o[d0][4 * g4 + 3] * inv);
    return lt;
}
#define STAGE_V32(vbuf, ROWP) do { _Pragma("unroll") for (int _i = 0; _i < 4; ++_i) { const int _key = (lane >> 3) + 8 * _i, _ch = lane & 7; \
        const u32x4 _v = *(const u32x4*)((ROWP(_key)) + 8 * _ch); *(LAS u32x4*)((vbuf) + (_ch >> 2) * 2048 + _key * 64 + (_ch & 3) * 16) = _v; } } while (0)

template <int DHS>
__device__ __forceinline__ void attn_pair(AttnAcc& st, f32x16& s0, f32x16& s1, const bool has2, LAS const char* vb0, LAS const char* vb1, int lane) {
    const int hi = lane >> 5, g1 = (lane >> 4) & 1, q4 = (lane & 15) >> 2, p4 = lane & 3;
    const int voff = (4 * hi + q4) * 64 + g1 * 32 + p4 * 8;
    bf16x8 vfa[2][2], vfb[2][2];
#pragma unroll
    for (int d0 = 0; d0 < 2; ++d0)
#pragma unroll
        for (int s2 = 0; s2 < 2; ++s2) { LAS const char* p = vb0 + voff + d0 * DHS + s2 * 1024; vfa[d0][s2] = cat8(trr(p), trr(p + 512)); vfb[d0][s2] = vfa[d0][s2]; }
    if (has2) {
#pragma unroll
        for (int d0 = 0; d0 < 2; ++d0)
#pragma unroll
            for (int s2 = 0; s2 < 2; ++s2) { LAS const char* p = vb1 + voff + d0 * DHS + s2 * 1024; vfb[d0][s2] = cat8(trr(p), trr(p + 512)); }
    }
    __builtin_amdgcn_sched_barrier(0);
    float mx = s0[0];
#pragma unroll
    for (int r = 1; r < 16; ++r) mx = fmaxf(mx, s0[r]);
    if (has2) {
#pragma unroll
        for (int r = 0; r < 16; ++r) mx = fmaxf(mx, s1[r]);
    }
    mx = xhalf_max(mx);
    const float mn = fmaxf(st.m, mx);
    const float mu = (mn == -__builtin_inff()) ? 0.f : mn;
    const float alpha = __builtin_amdgcn_exp2f(st.m - mu);
    float sum = 0.f;
#pragma unroll
    for (int r = 0; r < 16; ++r) { s0[r] = __builtin_amdgcn_exp2f(s0[r] - mu); sum += s0[r]; }
    if (has2) {
#pragma unroll
        for (int r = 0; r < 16; ++r) { s1[r] = __builtin_amdgcn_exp2f(s1[r] - mu); sum += s1[r]; }
    }
    st.l = st.l * alpha + sum; st.m = mn;
    if (__builtin_amdgcn_ballot_w64(alpha != 1.0f) != 0ull) {
#pragma unroll
        for (int d0 = 0; d0 < 2; ++d0)
#pragma unroll
            for (int r = 0; r < 16; ++r) st.o[d0][r] *= alpha;
    }
    {
        u32x4 w0, w1;
        w0.x = cvt_pk_bf16(s0[0], s0[1]); w0.y = cvt_pk_bf16(s0[2], s0[3]); w0.z = cvt_pk_bf16(s0[4], s0[5]); w0.w = cvt_pk_bf16(s0[6], s0[7]);
        w1.x = cvt_pk_bf16(s0[8], s0[9]); w1.y = cvt_pk_bf16(s0[10], s0[11]); w1.z = cvt_pk_bf16(s0[12], s0[13]); w1.w = cvt_pk_bf16(s0[14], s0[15]);
        const bf16x8 pb0 = __builtin_bit_cast(bf16x8, w0), pb1 = __builtin_bit_cast(bf16x8, w1);
#pragma unroll
        for (int d0 = 0; d0 < 2; ++d0)
#pragma unroll
            for (int s2 = 0; s2 < 2; ++s2) st.o[d0] = __builtin_amdgcn_mfma_f32_32x32x16_bf16(vfa[d0][s2], s2 ? pb1 : pb0, st.o[d0], 0, 0, 0);
    }
    if (has2) {
        u32x4 w0, w1;
        w0.x = cvt_pk_bf16(s1[0], s1[1]); w0.y = cvt_pk_bf16(s1[2], s1[3]); w0.z = cvt_pk_bf16(s1[4], s1[5]); w0.w = cvt_pk_bf16(s1[6], s1[7]);
        w1.x = cvt_pk_bf16(s1[8], s1[9]); w1.y = cvt_pk_bf16(s1[10], s1[11]); w1.z = cvt_pk_bf16(s1[12], s1[13]); w1.w = cvt_pk_bf16(s1[14], s1[15]);
        const bf16x8 pb0 = __builtin_bit_cast(bf16x8, w0), pb1 = __builtin_bit_cast(bf16x8, w1);
#pragma unroll
        for (int d0 = 0; d0 < 2; ++d0)
#pragma unroll
            for (int s2 = 0; s2 < 2; ++s2) st.o[d0] = __builtin_amdgcn_mfma_f32_32x32x16_bf16(vfb[d0][s2], s2 ? pb1 : pb0, st.o[d0], 0, 0, 0);
    }
}
#define DMA_V32(ldsbuf, VROW) do { const bf16_t* _ra = (VROW(lane >> 2)) + (lane & 3) * 8; const bf16_t* _rb = (VROW(16 + (lane >> 2))) + (lane & 3) * 8; \
        __builtin_amdgcn_global_load_lds((const unsigned*)_ra, (LAS unsigned*)(ldsbuf), 16, 0, 0); \
        __builtin_amdgcn_global_load_lds((const unsigned*)_rb, (LAS unsigned*)((ldsbuf) + 1024), 16, 0, 0); \
        __builtin_amdgcn_global_load_lds((const unsigned*)(_ra + 32), (LAS unsigned*)((ldsbuf) + 2048), 16, 0, 0); \
        __builtin_amdgcn_global_load_lds((const unsigned*)(_rb + 32), (LAS unsigned*)((ldsbuf) + 3072), 16, 0, 0); } while (0)
#define CBAR() asm volatile("" ::: "memory")
#define WAIT_GROUP_V(nblk_next) do { if ((nblk_next) == 2) asm volatile("s_waitcnt vmcnt(16)" ::: "memory"); else if ((nblk_next) == 1) asm volatile("s_waitcnt vmcnt(8)" ::: "memory"); else asm volatile("s_waitcnt vmcnt(0)" ::: "memory"); } while (0)

__device__ __forceinline__ void phase_dilated(const Ctx& F, const Args& a) {
    unsigned char* ws = a.ws;
    const bf16_t* proj = (const bf16_t*)(ws + AR_PROJ); bf16_t* dilp = (bf16_t*)(ws + AR_DILP); float* dlse = (float*)(ws + AR_DLSE);
    const int gw = F.vcu * 8 + F.wave, NGW = F.G * 8, lane = F.lane, hi = lane >> 5, r32 = lane & 31;
    LAS char* vbuf = (LAS char*)F.lds + F.wave * 16384;
    const float sc2 = 0.125f * LOG2E;
    for (int u = gw; u < 3 * 4096; u += NGW) {
        const int br = u >> 12, v = u & 4095; const int dsh = 2 * br, d = 1 << dsh, sub = T >> dsh, nblk = sub >> 5;
        const int h = v & 7; int rest = v >> 3; const int sb = rest % nblk; rest /= nblk; const int rr = rest & (d - 1), b = rest >> dsh;
        const int s0 = 32 * sb; const size_t rowb = (size_t)b * T;
        const size_t rowq = rowb + (size_t)(s0 + r32) * d + rr;
        bf16x8 qf[4];
#pragma unroll
        for (int d0 = 0; d0 < 4; ++d0) qf[d0] = *(const bf16x8*)(proj + rowq * DINP + C_DLQ + h * 64 + 16 * d0 + 8 * hi);
        AttnAcc st; attn_init(st);
        const int kb_lo = (s0 < 64) ? ((64 - s0) >> 5) : 0; const int kb_hi = min(4, (sub - 1 - (s0 - 64)) >> 5);
        const int nb = kb_hi - kb_lo + 1, ng = (nb + 1) >> 1;
#define DIL_KROW(kb_, i) (rowb + (size_t)(s0 - 64 + 32 * (kb_) + (i)) * d + rr)
#define DIL_VROW0(k) (proj + DIL_KROW(kbA, (k)) * DINP + C_DLV + h * 64)
#define DIL_VROW1(k) (proj + DIL_KROW(kbA + 1, (k)) * DINP + C_DLV + h * 64)
#define DIL_ISSUE(g_, KF) do { const int kbA = kb_lo + 2 * (g_); const bool two_ = (kbA + 1 <= kb_hi); LAS char* vb_ = vbuf + ((g_) & 1) * 8192; \
            { const bf16_t* kp_ = proj + DIL_KROW(kbA, r32) * DINP + C_DLK + h * 64 + 8 * hi; _Pragma("unroll") for (int d0 = 0; d0 < 4; ++d0) KF[0][d0] = *(const bf16x8*)(kp_ + 16 * d0); } \
            DMA_V32(vb_, DIL_VROW0); \
            if (two_) { const bf16_t* kp_ = proj + DIL_KROW(kbA + 1, r32) * DINP + C_DLK + h * 64 + 8 * hi; _Pragma("unroll") for (int d0 = 0; d0 < 4; ++d0) KF[1][d0] = *(const bf16x8*)(kp_ + 16 * d0); \
                DMA_V32(vb_ + 4096, DIL_VROW1); } } while (0)
        bf16x8 kfn[2][4];
#pragma unroll
        for (int d0 = 0; d0 < 4; ++d0) kfn[1][d0] = kfn[0][d0] = (bf16x8){0, 0, 0, 0, 0, 0, 0, 0};
        CBAR(); DIL_ISSUE(0, kfn); CBAR();
#pragma unroll 1
        for (int g = 0; g < ng; ++g) {
            const int kbA = kb_lo + 2 * g; const bool has2 = (kbA + 1 <= kb_hi);
            bf16x8 kf[2][4];
#pragma unroll
            for (int d0 = 0; d0 < 4; ++d0) { kf[0][d0] = kfn[0][d0]; kf[1][d0] = kfn[1][d0]; }
            const int nnext = (g + 1 < ng) ? ((kbA + 3 <= kb_hi) ? 2 : 1) : 0;
            CBAR(); if (g + 1 < ng) DIL_ISSUE(g + 1, kfn); CBAR();
            f32x16 p0 = f32x16{}, p1 = f32x16{};
#pragma unroll
            for (int d0 = 0; d0 < 4; ++d0) p0 = __builtin_amdgcn_mfma_f32_32x32x16_bf16(kf[0][d0], qf[d0], p0, 0, 0, 0);
            if (has2) {
#pragma unroll
                for (int d0 = 0; d0 < 4; ++d0) p1 = __builtin_amdgcn_mfma_f32_32x32x16_bf16(kf[1][d0], qf[d0], p1, 0, 0, 0);
            }
#pragma unroll
            for (int r = 0; r < 16; ++r) { const int cr = crow(r, hi);
                const bool okA = (kbA == 0) ? (cr >= r32) : ((kbA == 4) ? (cr <= r32) : true); p0[r] = okA ? p0[r] * sc2 : -__builtin_inff();
                const bool okB = (kbA + 1 == 4) ? (cr <= r32) : true; p1[r] = okB ? p1[r] * sc2 : -__builtin_inff(); }
            WAIT_GROUP_V(nnext);
            attn_pair<2048>(st, p0, p1, has2, vbuf + (g & 1) * 8192, vbuf + (g & 1) * 8192 + 4096, lane);
            CBAR();
        }
#undef DIL_ISSUE
#undef DIL_VROW0
#undef DIL_VROW1
#undef DIL_KROW
        const float lt = attn_store_f8(st, (unsigned char*)dilp + ((size_t)br * M + rowq) * 512 + h * 64, lane);
        if (hi == 0) dlse[((size_t)br * M + rowq) * 8 + h] = (st.m + __log2f(lt)) * (1.0f / LOG2E);
    }
}

__device__ __forceinline__ void phase_na(const Ctx& F, const Args& a, int l) {
    unsigned char* ws = a.ws;
    const bf16_t* proj = (const bf16_t*)(ws + AR_PROJ); bf16_t* mixed = (bf16_t*)(ws + AR_MIXED);
    const int gw = F.vcu * 8 + F.wave, NGW = F.G * 8, lane = F.lane, hi = lane >> 5, r32 = lane & 31;
    LAS char* vbuf = (LAS char*)F.lds + F.wave * 16384;
    LAS float* rpbL = (LAS float*)(F.lds + 131072);
    { const float* rpb = a.in[I_NA_RPB] + (size_t)l * 8 * 15 * 31;
      for (int i = F.tid; i < 8 * 15 * 32; i += 512) { const int c = i & 31, hr = i >> 5; rpbL[i] = c < 31 ? rpb[hr * 31 + c] * LOG2E : 0.f; } }
    __syncthreads();
    const float sc2 = 0.125f * LOG2E;
    for (int u = gw; u < 4096; u += NGW) {
        const int h = u & 7, cb = (u >> 3) & 3, rp = (u >> 5) & 31, b = u >> 10;
        const int qrow = 2 * rp + (r32 >> 4), qc = 16 * cb + (r32 & 15); const size_t rowq = (size_t)b * T + qrow * 64 + qc;
        const int qs = min(max(qc - 8, 0), 48), rsq = min(max(qrow - 4, 0), 56);
        const int c0 = min(max(16 * cb - 8, 0), 32), rs0 = min(max(2 * rp - 4, 0), 56), rs1 = min(max(2 * rp - 3, 0), 56);
        const int nb = 8 + (rs1 - rs0), ng = (nb + 1) >> 1;
        bf16x8 qf[4];
#pragma unroll
        for (int d0 = 0; d0 < 4; ++d0) qf[d0] = *(const bf16x8*)(proj + rowq * DINP + C_NAQ + h * 64 + 16 * d0 + 8 * hi);
        AttnAcc st; attn_init(st);
        const size_t rowk0 = (size_t)b * T + rs0 * 64 + c0;
        const int cbase = c0 + 4 * hi - qs;
        const int bbase = c0 + 4 * hi - qc + 15;
#define NA_VROW0(k) (proj + (rowk0 + 64 * jA + (k)) * DINP + C_NAV + h * 64)
#define NA_VROW1(k) (proj + (rowk0 + 64 * (jA + 1) + (k)) * DINP + C_NAV + h * 64)
#define NA_ISSUE(g_, KF) do { const int jA = 2 * (g_); const bool two_ = (jA + 1 < nb); LAS char* vb_ = vbuf + ((g_) & 1) * 8192; \
            { const bf16_t* kp_ = proj + (rowk0 + 64 * jA + r32) * DINP + C_NAK + h * 64 + 8 * hi; _Pragma("unroll") for (int d0 = 0; d0 < 4; ++d0) KF[0][d0] = *(const bf16x8*)(kp_ + 16 * d0); } \
            DMA_V32(vb_, NA_VROW0); \
            if (two_) { const bf16_t* kp_ = proj + (rowk0 + 64 * (jA + 1) + r32) * DINP + C_NAK + h * 64 + 8 * hi; _Pragma("unroll") for (int d0 = 0; d0 < 4; ++d0) KF[1][d0] = *(const bf16x8*)(kp_ + 16 * d0); \
                DMA_V32(vb_ + 4096, NA_VROW1); } } while (0)
        bf16x8 kfn[2][4];
#pragma unroll
        for (int d0 = 0; d0 < 4; ++d0) kfn[1][d0] = kfn[0][d0] = (bf16x8){0, 0, 0, 0, 0, 0, 0, 0};
        CBAR(); NA_ISSUE(0, kfn); CBAR();
#pragma unroll 1
        for (int g = 0; g < ng; ++g) {
            const int jA = 2 * g; const bool has2 = (jA + 1 < nb);
            bf16x8 kf[2][4];
#pragma unroll
            for (int d0 = 0; d0 < 4; ++d0) { kf[0][d0] = kfn[0][d0]; kf[1][d0] = kfn[1][d0]; }
            const int nnext = (g + 1 < ng) ? ((jA + 3 < nb) ? 2 : 1) : 0;
            CBAR(); if (g + 1 < ng) NA_ISSUE(g + 1, kfn); CBAR();
            f32x16 p0 = f32x16{}, p1 = f32x16{};
#pragma unroll
            for (int d0 = 0; d0 < 4; ++d0) p0 = __builtin_amdgcn_mfma_f32_32x32x16_bf16(kf[0][d0], qf[d0], p0, 0, 0, 0);
            if (has2) {
#pragma unroll
                for (int d0 = 0; d0 < 4; ++d0) p1 = __builtin_amdgcn_mfma_f32_32x32x16_bf16(kf[1][d0], qf[d0], p1, 0, 0, 0);
            }
            const int krA = rs0 + jA; const bool rowA = (unsigned)(krA - rsq) < 8u, rowB = (unsigned)(krA + 1 - rsq) < 8u;
            const int roA = min(max(krA - qrow + 7, 0), 14), roB = min(max(krA + 1 - qrow + 7, 0), 14);
            LAS const float* bA = rpbL + (h * 15 + roA) * 32; LAS const float* bB = rpbL + (h * 15 + roB) * 32;
#pragma unroll
            for (int r = 0; r < 16; ++r) { const int cr = (r & 3) + 8 * (r >> 2); const bool colok = (unsigned)(cbase + cr) < 16u; const int bc = min(max(bbase + cr, 0), 30);
                p0[r] = (colok && rowA) ? (p0[r] * sc2 + bA[bc]) : -__builtin_inff();
                p1[r] = (colok && rowB) ? (p1[r] * sc2 + bB[bc]) : -__builtin_inff(); }
            WAIT_GROUP_V(nnext);
            attn_pair<2048>(st, p0, p1, has2, vbuf + (g & 1) * 8192, vbuf + (g & 1) * 8192 + 4096, lane);
            CBAR();
        }
#undef NA_ISSUE
#undef NA_VROW0
#undef NA_VROW1
        (void)attn_store(st, mixed + rowq * D + 512 + h * 64, lane);
    }
    __syncthreads();
}

#ifndef MLA_THR
#define MLA_THR 8.0f
#endif
__device__ __forceinline__ float max3f_(float a, float b, float c) { return __builtin_fmaxf(__builtin_fmaxf(a, b), c); }
__device__ __forceinline__ void mla_tile(AttnAcc& st, float& mhat, f32x16& negm, f32x16& p0, f32x16& p1, const bool first, const bf16x8 (&vf)[2][2][2]) {
    float a = max3f_(p0[0], p0[1], p1[0]), b = max3f_(p0[2], p0[3], p1[1]); a = max3f_(a, p1[2], p1[3]);
#pragma unroll
    for (int r = 4; r < 16; r += 4) { a = max3f_(a, p0[r], p0[r + 1]); b = max3f_(b, p0[r + 2], p0[r + 3]); a = max3f_(a, p1[r], p1[r + 1]); b = max3f_(b, p1[r + 2], p1[r + 3]); }
    const float rm = xhalf_max(__builtin_fmaxf(a, b));
    if (first || __builtin_amdgcn_ballot_w64(rm > MLA_THR) != 0ull) {
        const float dl = first ? rm : __builtin_fmaxf(rm, 0.f);
        mhat += dl;
#pragma unroll
        for (int r = 0; r < 16; ++r) { p0[r] -= dl; p1[r] -= dl; negm[r] = -mhat; }
        asm volatile("" : "+v"(negm));
        if (!first) { const float f = __builtin_amdgcn_exp2f(-dl); st.l *= f;
#pragma unroll
            for (int d0 = 0; d0 < 2; ++d0)
#pragma unroll
                for (int r = 0; r < 16; ++r) st.o[d0][r] *= f; }
    }
    float sum = 0.f;
#pragma unroll
    for (int r = 0; r < 16; ++r) { p0[r] = __builtin_amdgcn_exp2f(p0[r]); p1[r] = __builtin_amdgcn_exp2f(p1[r]); sum += p0[r] + p1[r]; }
    st.l += sum;
#pragma unroll
    for (int blk = 0; blk < 2; ++blk) { const f32x16& s = blk ? p1 : p0;
        u32x4 w0, w1;
        w0.x = cvt_pk_bf16(s[0], s[1]); w0.y = cvt_pk_bf16(s[2], s[3]); w0.z = cvt_pk_bf16(s[4], s[5]); w0.w = cvt_pk_bf16(s[6], s[7]);
        w1.x = cvt_pk_bf16(s[8], s[9]); w1.y = cvt_pk_bf16(s[10], s[11]); w1.z = cvt_pk_bf16(s[12], s[13]); w1.w = cvt_pk_bf16(s[14], s[15]);
        const bf16x8 pb0 = __builtin_bit_cast(bf16x8, w0), pb1 = __builtin_bit_cast(bf16x8, w1);
#pragma unroll
        for (int d0 = 0; d0 < 2; ++d0)
#pragma unroll
            for (int s2 = 0; s2 < 2; ++s2) st.o[d0] = __builtin_amdgcn_mfma_f32_32x32x16_bf16(vf[blk][d0][s2], s2 ? pb1 : pb0, st.o[d0], 0, 0, 0); }
}
__device__ __forceinline__ void phase_mla(const Ctx& F, const Args& a, const int conv_list, const int conv_every) {
    unsigned char* ws = a.ws;
    const bf16_t* proj = (const bf16_t*)(ws + AR_PROJ); const bf16_t* qm = (const bf16_t*)(ws + AR_QMLA); const bf16_t* kv = qm + 768;   bf16_t* mixed = (bf16_t*)(ws + AR_MIXED);
    const f32x2* rope = (const f32x2*)(ws + WS_ROPE);
    const int lane = F.lane, wave = F.wave, tid = F.tid, hi = lane >> 5, r32 = lane & 31;
    LAS char* lds = (LAS char*)F.lds;
    constexpr int KB = 12288, VB = 8192, VOFF = 2 * KB;
    const float qscale = 0.10206207261596577f * LOG2E;
    LAS float* cscr = (LAS float*)(lds + 65536 + wave * 8448);
    const int cstride = F.G * 8; int cit = F.vcu * 8 + wave; ConvJob cj; f32x4 cv[8]; bool cpend = false; int ctick = 0;
#pragma unroll
    for (int i = 0; i < 8; ++i) cv[i] = (f32x4){0.f, 0.f, 0.f, 0.f};
    for (int u = F.vcu; u < NB * 8 * 16; u += F.G) {
        const int bh = u >> 4, qb = u & 15, b = bh >> 3, h = bh & 7;
        const size_t rowb = (size_t)b * T; const int tq = qb * 256 + wave * 32 + r32; const size_t rowq = rowb + tq;
        bf16x8 qf[6];
        {
            float qv[6][8]; u32x4 qraw[6]; f32x2 csr[8];
#pragma unroll
            for (int d0 = 0; d0 < 6; ++d0) qraw[d0] = *(const u32x4*)(qm + rowq * 1792 + h * 96 + 16 * d0 + 8 * hi);
#pragma unroll
            for (int j = 0; j < 8; ++j) csr[j] = rope[(size_t)tq * 32 + 2 * (8 * hi + j)];
            __builtin_amdgcn_sched_barrier(0);
#pragma unroll
            for (int d0 = 0; d0 < 6; ++d0) { const unsigned xs[4] = {qraw[d0].x, qraw[d0].y, qraw[d0].z, qraw[d0].w};
#pragma unroll
                for (int j = 0; j < 4; ++j) { qv[d0][2 * j] = bf_lo(xs[j]); qv[d0][2 * j + 1] = bf_hi(xs[j]); } }
#pragma unroll
            for (int j = 0; j < 8; ++j) { const f32x2 cs = csr[j]; const float x1 = qv[4][j], x2 = qv[5][j]; qv[4][j] = x1 * cs.x - x2 * cs.y; qv[5][j] = x2 * cs.x + x1 * cs.y; }
#pragma unroll
            for (int d0 = 0; d0 < 6; ++d0) { u32x4 w; w.x = cvt_pk_bf16(qv[d0][0] * qscale, qv[d0][1] * qscale); w.y = cvt_pk_bf16(qv[d0][2] * qscale, qv[d0][3] * qscale);
                w.z = cvt_pk_bf16(qv[d0][4] * qscale, qv[d0][5] * qscale); w.w = cvt_pk_bf16(qv[d0][6] * qscale, qv[d0][7] * qscale); qf[d0] = __builtin_bit_cast(bf16x8, w); }
        }
        AttnAcc st; attn_init(st); float mhat = 0.f; f32x16 negm = f32x16{};
        const int key8 = tid >> 3, c8 = tid & 7, key4 = tid >> 2, c4 = tid & 3;
        const bf16_t* ksrc = kv + (rowb + key8) * 1792 + h * 128 + 8 * c8;
        const bf16_t* vsrc = ksrc + 64;
        const bf16_t* psrc = proj + (rowb + key4) * DINP + C_KR + 8 * c4;
        const int kdst = c8 * 1024 + key8 * 16, pdst = (8 + c4) * 1024 + key4 * 16, vdst = VOFF + (c8 >> 2) * 4096 + key8 * 64 + (c8 & 3) * 16;
        u32x4 kr0, kr1 = (u32x4){0u, 0u, 0u, 0u}, vr;
        kr0 = *(const u32x4*)ksrc; vr = *(const u32x4*)vsrc; if (tid < 256) kr1 = *(const u32x4*)psrc;
        *(LAS u32x4*)(lds + kdst) = kr0; *(LAS u32x4*)(lds + vdst) = vr; if (tid < 256) *(LAS u32x4*)(lds + pdst) = kr1;
        __syncthreads();
#pragma unroll 1
        for (int t = 0; t < 64; ++t) {
            const int cur = t & 1;
            if (t + 1 < 64) { const size_t o = (size_t)(t + 1) * 64; kr0 = *(const u32x4*)(ksrc + o * 1792); vr = *(const u32x4*)(vsrc + o * 1792); if (tid < 256) kr1 = *(const u32x4*)(psrc + o * DINP); }
            LAS const char* kb = lds + cur * KB; LAS const char* vb = lds + VOFF + cur * VB;
            {
                bf16x8 kfa[6], kfb[6];
#pragma unroll
                for (int d0 = 0; d0 < 6; ++d0) { kfa[d0] = *(LAS const bf16x8*)(kb + (2 * d0 + hi) * 1024 + r32 * 16); kfb[d0] = *(LAS const bf16x8*)(kb + (2 * d0 + hi) * 1024 + (32 + r32) * 16); }
                __builtin_amdgcn_sched_barrier(0);
                f32x16 p0 = negm, p1 = negm;
#pragma unroll
                for (int d0 = 0; d0 < 6; ++d0) { p0 = __builtin_amdgcn_mfma_f32_32x32x16_bf16(kfa[d0], qf[d0], p0, 0, 0, 0); p1 = __builtin_amdgcn_mfma_f32_32x32x16_bf16(kfb[d0], qf[d0], p1, 0, 0, 0); }
                __builtin_amdgcn_sched_barrier(0);
                bf16x8 vf[2][2][2];
                { const int g1 = (lane >> 4) & 1, q4 = (lane & 15) >> 2, p4 = lane & 3; LAS const char* vbase = vb + (4 * hi + q4) * 64 + g1 * 32 + p4 * 8;
#pragma unroll
                  for (int blk = 0; blk < 2; ++blk)
#pragma unroll
                    for (int d0 = 0; d0 < 2; ++d0)
#pragma unroll
                        for (int s2 = 0; s2 < 2; ++s2) { LAS const char* pp = vbase + blk * 2048 + d0 * 4096 + s2 * 1024; vf[blk][d0][s2] = cat8(trr(pp), trr(pp + 512)); } }
                __builtin_amdgcn_sched_barrier(0);
                mla_tile(st, mhat, negm, p0, p1, t == 0, vf);
            }
            if (t + 1 < 64) { const int nx = (cur ^ 1); *(LAS u32x4*)(lds + nx * KB + kdst) = kr0; *(LAS u32x4*)(lds + nx * VB + vdst) = vr; if (tid < 256) *(LAS u32x4*)(lds + nx * KB + pdst) = kr1; }
            if (++ctick >= conv_every) { ctick = 0;
                if (cpend) { conv_finish(cj, cv, cscr, lane); cpend = false; cit += cstride; }
                if (conv_decode(a, conv_list, cit, cj)) { conv_issue(cj, cv, lane); cpend = true; } }
            __syncthreads();
        }
        (void)attn_store(st, mixed + rowq * D + 1024 + h * 64, lane);
    }
    for (;;) { if (cpend) { conv_finish(cj, cv, cscr, lane); cpend = false; cit += cstride; }
        if (!conv_decode(a, conv_list, cit, cj)) break; conv_issue(cj, cv, lane); cpend = true; }
}

__device__ __forceinline__ void phase_dilated_wg(const Ctx& F, const Args& a) {
    unsigned char* ws = a.ws;
    const bf16_t* proj = (const bf16_t*)(ws + AR_PROJ); bf16_t* dilp = (bf16_t*)(ws + AR_DILP); float* dlse = (float*)(ws + AR_DLSE);
    const int lane = F.lane, wave = F.wave, hi = lane >> 5, r32 = lane & 31, g1 = (lane >> 4) & 1, q4 = (lane & 15) >> 2, p4 = lane & 3;
    LAS char* kimg = (LAS char*)F.lds; LAS char* vimg = kimg + 49152;
    const float sc2 = 0.125f * LOG2E;
    for (int u = F.bx; u < 3 * 512; u += F.G) {
        const int br = u >> 9, v = u & 511; const int dsh = 2 * br, d = 1 << dsh, sub = T >> dsh, nsb = sub >> 8;
        const int h = v & 7; int rest = v >> 3; const int SB = rest % nsb; rest /= nsb; const int rr = rest & (d - 1), b = rest >> dsh;
        const size_t rowb = (size_t)b * T; const int sbase = 256 * SB - 64;
        CBAR();
#pragma unroll
        for (int i = 0; i < 6; ++i) { const int piece = wave + 8 * i; const int m0 = 8 * piece; const int s_first = sbase + (m0 & ~31);
            if (s_first >= 0 && s_first < sub) { const int m = m0 + (lane >> 3); const int cg = (lane & 7) ^ (m & 7);
                const bf16_t* rp = proj + (rowb + (size_t)(sbase + m) * d + rr) * DINP + h * 64 + cg * 8;
                __builtin_amdgcn_global_load_lds((const unsigned*)(rp + C_DLK), (LAS unsigned*)(kimg + m0 * 128), 16, 0, 0);
                __builtin_amdgcn_global_load_lds((const unsigned*)(rp + C_DLV), (LAS unsigned*)(vimg + m0 * 128), 16, 0, 0); } }
        CBAR();
        const int s0 = 256 * SB + 32 * wave; const size_t rowq = rowb + (size_t)(s0 + r32) * d + rr;
        bf16x8 qf[4];
#pragma unroll
        for (int d0 = 0; d0 < 4; ++d0) qf[d0] = *(const bf16x8*)(proj + rowq * DINP + C_DLQ + h * 64 + 16 * d0 + 8 * hi);
        AttnAcc st; attn_init(st);
        const int kb_lo = (s0 < 64) ? ((64 - s0) >> 5) : 0; const int kb_hi = min(4, (sub - 1 - (s0 - 64)) >> 5);
        asm volatile("s_waitcnt vmcnt(0)" ::: "memory");
        __syncthreads();
#pragma unroll 1
        for (int kb = kb_lo; kb <= kb_hi; ++kb) {
            const int mrow = 32 * wave + 32 * kb + r32;
            bf16x8 kf[4], vf[2][2]; const int mblk = 32 * wave + 32 * kb;
#pragma unroll
            for (int d0 = 0; d0 < 4; ++d0) kf[d0] = *(LAS const bf16x8*)(kimg + mrow * 128 + (((2 * d0 + hi) ^ (mrow & 7)) * 16));
#pragma unroll
            for (int d0 = 0; d0 < 2; ++d0)
#pragma unroll
                for (int s2 = 0; s2 < 2; ++s2) { const int key = mblk + 16 * s2 + 4 * hi + q4; const int cchunk = 4 * d0 + 2 * g1 + (p4 >> 1);
                    vf[d0][s2] = cat8(trr(vimg + key * 128 + ((cchunk ^ (key & 7)) * 16) + (p4 & 1) * 8), trr(vimg + (key + 8) * 128 + ((cchunk ^ ((key + 8) & 7)) * 16) + (p4 & 1) * 8)); }
            __builtin_amdgcn_sched_barrier(0);
            f32x16 p = f32x16{};
#pragma unroll
            for (int d0 = 0; d0 < 4; ++d0) p = __builtin_amdgcn_mfma_f32_32x32x16_bf16(kf[d0], qf[d0], p, 0, 0, 0);
#pragma unroll
            for (int r = 0; r < 16; ++r) { const int cr = crow(r, hi); const bool ok = (kb == 0) ? (cr >= r32) : ((kb == 4) ? (cr <= r32) : true); p[r] = ok ? p[r] * sc2 : -__builtin_inff(); }
            float mx = p[0];
#pragma unroll
            for (int r = 1; r < 16; ++r) mx = fmaxf(mx, p[r]);
            mx = xhalf_max(mx);
            const float mn = fmaxf(st.m, mx); const float mu = (mn == -__builtin_inff()) ? 0.f : mn; const float alpha = __builtin_amdgcn_exp2f(st.m - mu);
            float sum = 0.f;
#pragma unroll
            for (int r = 0; r < 16; ++r) { p[r] = __builtin_amdgcn_exp2f(p[r] - mu); sum += p[r]; }
            st.l = st.l * alpha + sum; st.m = mn;
            if (__builtin_amdgcn_ballot_w64(alpha != 1.0f) != 0ull) {
#pragma unroll
                for (int d0 = 0; d0 < 2; ++d0)
#pragma unroll
                    for (int r = 0; r < 16; ++r) st.o[d0][r] *= alpha; }
            u32x4 w0, w1;
            w0.x = cvt_pk_bf16(p[0], p[1]); w0.y = cvt_pk_bf16(p[2], p[3]); w0.z = cvt_pk_bf16(p[4], p[5]); w0.w = cvt_pk_bf16(p[6], p[7]);
            w1.x = cvt_pk_bf16(p[8], p[9]); w1.y = cvt_pk_bf16(p[10], p[11]); w1.z = cvt_pk_bf16(p[12], p[13]); w1.w = cvt_pk_bf16(p[14], p[15]);
            const bf16x8 pb0 = __builtin_bit_cast(bf16x8, w0), pb1 = __builtin_bit_cast(bf16x8, w1);
#pragma unroll
            for (int d0 = 0; d0 < 2; ++d0)
#pragma unroll
                for (int s2 = 0; s2 < 2; ++s2) st.o[d0] = __builtin_amdgcn_mfma_f32_32x32x16_bf16(vf[d0][s2], s2 ? pb1 : pb0, st.o[d0], 0, 0, 0);
        }
        const float lt = attn_store_f8(st, (unsigned char*)dilp + ((size_t)br * M + rowq) * 512 + h * 64, lane);
        if (hi == 0) dlse[((size_t)br * M + rowq) * 8 + h] = (st.m + __log2f(lt)) * (1.0f / LOG2E);
        __syncthreads();
    }
}

__device__ __forceinline__ void phase_moe_gather(const Ctx& F, const Args& a) {
    unsigned char* ws = a.ws;
    const int* histo = (const int*)(ws + WS_HISTO); int* tpg = (int*)(ws + WS_TP); int* rowtok = (int*)(ws + WS_ROWTOK); float* rowgate = (float*)(ws + WS_ROWGATE);
    const bf16_t* H = (const bf16_t*)(ws + WS_H); unsigned char* HG = ws + AR_HG;
    LAS int* tot = (LAS int*)F.lds; LAS int* base = tot + 8; LAS int* seg = tot + 16; LAS int* slots = tot + 32;
    const int lane = F.lane, wave = F.wave, w = F.bx, rows_per_wg = M / F.G;
    {
        const int e = wave; int t = 0, bsum = 0;
        for (int j = lane; j < F.G; j += 64) { const int c = histo[j * 8 + e]; t += c; if (j < w) bsum += c; }
        t = wave_sum_i(t); bsum = wave_sum_i(bsum);
        if (lane == 0) { tot[e] = t; base[e] = bsum; }
    }
    __syncthreads();
    if (F.tid == 0) { int p = 0; for (int e = 0; e < 8; ++e) { seg[e] = p; p += (tot[e] + 255) >> 8; } seg[8] = p; if (w == 0) { for (int e = 0; e <= 8; ++e) tpg[e] = seg[e]; } }
    __syncthreads();
    if (wave == 0) {
        const bool act = lane < rows_per_wg; const int m = w * rows_per_wg + lane;
        u32x4 rt = (u32x4){0u, 0u, 0u, 0u}; if (act) rt = ((const u32x4*)(ws + WS_ROUTE))[m];
        const int ek[2] = {act ? (int)rt.x : -1, act ? (int)rt.y : -1}; const float gk[2] = {__uint_as_float(rt.z), __uint_as_float(rt.w)};
        int run[8];
#pragma unroll
        for (int e = 0; e < 8; ++e) run[e] = 0;
#pragma unroll
        for (int k = 0; k < 2; ++k)
#pragma unroll
            for (int e = 0; e < 8; ++e) { const unsigned long long mask = __ballot(ek[k] == e);
                if (ek[k] == e) { const int rank = __popcll(mask & ((1ull << lane) - 1ull)); const int slot = 256 * seg[e] + base[e] + run[e] + rank;
                    rowtok[slot] = m + k * M; rowgate[slot] = gk[k]; slots[lane * 2 + k] = slot; }
                run[e] += __popcll(mask); }
    }
    __syncthreads();
    if (w < 8) { const int e = w, r0 = 256 * seg[e] + tot[e], r1 = 256 * seg[e + 1];
        for (int r = r0 + F.tid; r < r1; r += 512) { rowtok[r] = -1; rowgate[r] = 0.f; } }
    __syncthreads();
}
template <int WGMT, bool GATHERF>
struct MoeSched {
    static constexpr bool GATHER = GATHERF;
    int tp[9]; int nN, G, c; const char* A; const char* B; size_t tA, tB, eB; const int* rowtok;
    __device__ __forceinline__ bool next(int i, pg8::Unit& u) const {
        if (!pg8::tile_of<WGMT>(i, G, c, tp[8], nN, u.pm, u.pn)) return false;
        int e = 0;
#pragma unroll
        for (int j = 1; j < 8; ++j) e += (u.pm >= tp[j]) ? 1 : 0;
        u.e = e; u.a = GATHERF ? A : A + (size_t)u.pm * tA; u.b = B + (size_t)e * eB + (size_t)u.pn * tB; return true;
    }
    __device__ __forceinline__ void gather(const pg8::Unit& u, int tid, unsigned (&off)[2][2]) const {
#pragma unroll
        for (int i = 0; i < 2; ++i) { int R, C; pg8::stage_rc(tid * 16 + i * 8192, R, C);
#pragma unroll
            for (int h = 0; h < 2; ++h) { const int rt = rowtok[u.pm * 256 + h * 128 + R]; const int tok = rt < 0 ? M : (rt >= M ? rt - M : rt); off[h][i] = (unsigned)tok * (unsigned)D + (unsigned)C * 2u; } }
    }
};

#ifndef WGM_INPROJ
#define WGM_INPROJ 4
#endif
#ifndef WGM_OUTPROJ
#define WGM_OUTPROJ 4
#endif
#ifndef WGM_GU
#define WGM_GU 16
#endif
#ifndef WGM_DOWN
#define WGM_DOWN 4
#endif
#ifndef WGM_MOEGU
#define WGM_MOEGU 16
#endif
#ifndef WGM_MOEDN
#define WGM_MOEDN 4
#endif
#ifndef WGM_MLAUP
#define WGM_MLAUP 4
#endif
#ifndef CONV_E0
#define CONV_E0 2
#endif
#ifndef CONV_E1
#define CONV_E1 3
#endif
#ifndef PH_MASK
#define PH_MASK 0xFFFFFFFFu
#endif
#ifndef REP_MASK
#define REP_MASK 0u
#endif
typedef const __attribute__((address_space(4))) Args KArgs;
__device__ __forceinline__ void load_args(KArgs* p, Args& a) {
#pragma unroll
    for (int i = 0; i < 24; ++i) a.in[i] = p->in[i];
    a.out = p->out; a.ws = p->ws; a.ph_lo = p->ph_lo; a.ph_hi = p->ph_hi;
}
#define PHASE_BEGIN(k) if (ph >= lo && ph < hi) { if ((PH_MASK >> (k)) & 1) for (int rep_ = 0; rep_ <= (int)((REP_MASK >> (k)) & 1u); ++rep_) { if (rep_) __syncthreads(); \
        Ctx F = F0; asm volatile("" : "+v"(F.tid)); F.lane = F.tid & 63; F.wave = __builtin_amdgcn_readfirstlane(F.tid >> 6); \
        KArgs* kp_ = ka; asm volatile("" : "+s"(kp_)); Args args; load_args(kp_, args); unsigned char* ws = args.ws; (void)ws;
#define RELAUNDER() do { asm volatile("" : "+v"(F.tid)); F.lane = F.tid & 63; F.wave = __builtin_amdgcn_readfirstlane(F.tid >> 6); KArgs* kp2_ = ka; asm volatile("" : "+s"(kp2_)); load_args(kp2_, args); ws = args.ws; } while (0)
#define PHASE_END   } if (ph + 1 < hi) xcd_barrier(bar); } ++ph;
#define X ((bf16_t*)(ws + WS_X))
#define H ((bf16_t*)(ws + WS_H))
#define PROJ ((bf16_t*)(ws + AR_PROJ))
#define MIXED ((bf16_t*)(ws + AR_MIXED))

template <int L>
__device__ __forceinline__ void layer_phases(const Ctx& F0, KArgs* ka, const XcdBarrier& bar, const int lo, const int hi, int& ph) {
    constexpr int l = L;

        if (l > 0 && !(NORM_FOLD && STATS_FUSED)) {
        PHASE_BEGIN(1)
#if NORM_FOLD
            phase_rowstats(F, X, (float*)(ws + WS_RSTD));
#else
            phase_rmsnorm_bf16(F, X, args.in[I_ATTN_NORM] + (size_t)l * D, H);
#endif
        PHASE_END
        } else ++ph;
        PHASE_BEGIN(2)
            if constexpr (NORM_FOLD && STATS_FUSED && l > 0) {
                pg8::Gemm g{D, D, D}; pg8::PlainSched<WGM_INPROJ> S{M / 256, DINP / 256, F.G, F.bx, (const char*)X, (const char*)(ws + WS_WIN + l * SZ_WIN), (size_t)256 * D * 2, (size_t)256 * D * 2};
                { const int mu = (S.nM * S.nN + F.G - 1) / F.G; pg8::fill_lrs(S, (const float*)(ws + WS_PART), F.lds, F.tid, mu < 23 ? mu : 23); }
                pg8::EpiBf16RL E{PROJ, DINP, (LAS const float*)(F.lds + pg8::LDS_LRS_OFF)};
                pg8::gemm_phase<false>(F.lds, F.tid, g, S, E);
            } else if constexpr (NORM_FOLD) {
                pg8::Gemm g{D, D, D}; pg8::PlainSched<WGM_INPROJ> S{M / 256, DINP / 256, F.G, F.bx, (const char*)X, (const char*)(ws + WS_WIN + l * SZ_WIN), (size_t)256 * D * 2, (size_t)256 * D * 2};
                pg8::EpiBf16R E{PROJ, DINP, (const float*)(ws + WS_RSTD)};
                pg8::gemm_phase<false>(F.lds, F.tid, g, S, E);
            } else {
                pg8::Gemm g{D, D, D}; pg8::PlainSched<WGM_INPROJ> S{M / 256, DINP / 256, F.G, F.bx, (const char*)H, (const char*)(ws + WS_WIN + l * SZ_WIN), (size_t)256 * D * 2, (size_t)256 * D * 2};
                pg8::EpiBf16 E{PROJ, DINP};
                pg8::gemm_phase<false>(F.lds, F.tid, g, S, E);
            }
        PHASE_END
        PHASE_BEGIN(3)
            phase_token_local(F, args, l);
#ifdef REP3
            RELAUNDER(); phase_token_local(F, args, l, true);
#endif
        PHASE_END
        PHASE_BEGIN(4)
            {
                struct MlaSched { enum { GATHER = 0 }; int G, c; const char* A; const char* B;
                    __device__ __forceinline__ void gather(const pg8::Unit&, int, unsigned (&)[2][2]) const {}
                    __device__ __forceinline__ bool next(int i, pg8::Unit& u) const { if (!pg8::tile_of<WGM_MLAUP>(i, G, c, M / 256, 7, u.pm, u.pn)) return false; u.e = 0;
                        u.a = A + (size_t)u.pm * 256 * DINP * 2 + (u.pn < 3 ? C_CQ : C_CKV) * 2; u.b = B + (size_t)u.pn * 256 * 512 * 2; return true; } };
                pg8::Gemm g{DINP, 512, 512}; MlaSched S{F.G, F.bx, (const char*)PROJ, (const char*)(ws + WS_WUQKV + l * SZ_WUQKV)};
#if NORM_FOLD
                pg8::EpiBf16R2 E{(bf16_t*)(ws + AR_QMLA), 1792, (const float*)(ws + WS_RSTD2)};
#else
                pg8::EpiBf16 E{(bf16_t*)(ws + AR_QMLA), 1792};
#endif
                pg8::gemm_phase<false>(F.lds, F.tid, g, S, E);
            }
            __syncthreads(); RELAUNDER();
            phase_ssm_states(F, args, l);
#ifdef REP4B
            __syncthreads(); RELAUNDER(); phase_ssm_states(F, args, l);
#endif
            __syncthreads(); RELAUNDER();
            phase_na(F, args, l);
#ifdef REP4C
            __syncthreads(); RELAUNDER(); phase_na(F, args, l);
#endif
            RELAUNDER();
#ifdef DIL_WAVE
            phase_dilated(F, args);
#else
            __syncthreads(); phase_dilated_wg(F, args);
#endif
#ifdef REP4D
            __syncthreads(); RELAUNDER(); phase_dilated_wg(F, args);
#endif
        PHASE_END
        PHASE_BEGIN(5)
            phase_ssm_scan(F, args);
            __syncthreads(); RELAUNDER();
            phase_mla(F, args, l, l == 0 ? CONV_E0 : CONV_E1);
        PHASE_END
        PHASE_BEGIN(6)
            phase_ssm_out(F, args, l);
            RELAUNDER();
            phase_dil_merge(F, args);
        PHASE_END
        PHASE_BEGIN(7)
            pg8::Gemm g{D, D, D}; pg8::PlainSched<WGM_OUTPROJ> S{M / 256, D / 256, F.G, F.bx, (const char*)MIXED, (const char*)(ws + WS_WO + l * SZ_WO), (size_t)256 * D * 2, (size_t)256 * D * 2};
            if constexpr (l == 0 && !NORM_FOLD) { pg8::EpiResB16<float> E{args.in[I_X], X, 1.0f}; pg8::gemm_phase<false>(F.lds, F.tid, g, S, E); }
            else if constexpr (l == 0 && NORM_FOLD && STATS_FUSED) { pg8::EpiResB16S E{X, X, 1.0f, (float*)(ws + WS_PART), (LAS float*)(F.lds + pg8::LDS_SS_OFF)}; pg8::gemm_phase<false>(F.lds, F.tid, g, S, E); }
            else { pg8::EpiResB16<bf16_t> E{X, X, 1.0f}; pg8::gemm_phase<false>(F.lds, F.tid, g, S, E); }
        PHASE_END
#if NORM_FOLD && STATS_FUSED && defined(DENSE_DOWN_F8)
        constexpr bool SKIP8 = (l == 0);
#else
        constexpr bool SKIP8 = false;
#endif
        if (SKIP8) ++ph; else {
        PHASE_BEGIN(8)
#ifdef DENSE_F8
            if (l == 0) phase_rmsnorm_f8(F, X, args.in[I_FFN_NORM] + (size_t)l * D, (unsigned char*)H);
#else
            if (l == 0) {
#if NORM_FOLD && defined(DENSE_DOWN_F8)
                phase_rowstats(F, X, (float*)(ws + WS_RSTD));
#else
                phase_rmsnorm_bf16(F, X, args.in[I_FFN_NORM] + (size_t)l * D, H);
#endif
            }
#endif
            else phase_rmsnorm_router(F, X, args.in[I_FFN_NORM] + (size_t)l * D, args.in[I_ROUTER], H, ws);
        PHASE_END
        }
        if (l == 0) {
            PHASE_BEGIN(9)
#ifdef DENSE_F8
                pg8::Gemm g{D / 2, D / 2, D / 2}; pg8::PlainSched<WGM_GU> S{M / 256, 2 * FF / 256, F.G, F.bx, (const char*)H, (const char*)(ws + WS_WGU), (size_t)256 * D, (size_t)256 * D};
                pg8::EpiSwiGluF8 E{ws + AR_HIDE, nullptr, 1.0f / WSCALE8};
                pg8::gemm_phase<true>(F.lds, F.tid, g, S, E);
#else
                pg8::Gemm g{D, D, D}; pg8::PlainSched<WGM_GU> S{M / 256, 2 * FF / 256, F.G, F.bx, (const char*)H, (const char*)(ws + WS_WGU), (size_t)256 * D * 2, (size_t)256 * D * 2};
#if defined(DENSE_DOWN_F8) && NORM_FOLD && STATS_FUSED
                S.A = (const char*)X;
                { const int mu = (S.nM * S.nN + F.G - 1) / F.G; pg8::fill_lrs(S, (const float*)(ws + WS_PART), F.lds, F.tid, mu < 23 ? mu : 23); }
                pg8::EpiSwiGluF8RL E{ws + AR_HIDE, (LAS const float*)(F.lds + pg8::LDS_LRS_OFF)};
#elif defined(DENSE_DOWN_F8) && NORM_FOLD
                S.A = (const char*)X;
                pg8::EpiSwiGluF8R E{ws + AR_HIDE, (const float*)(ws + WS_RSTD)};
#elif defined(DENSE_DOWN_F8)
                pg8::EpiSwiGluF8 E{ws + AR_HIDE, nullptr, 1.0f};
#else
                pg8::EpiSwiGlu E{(bf16_t*)(ws + AR_HIDE), nullptr};
#endif
                pg8::gemm_phase<false>(F.lds, F.tid, g, S, E);
#endif
            PHASE_END
#ifdef DUP9
            { Ctx F = F0; asm volatile("" : "+v"(F.tid)); F.lane = F.tid & 63; F.wave = __builtin_amdgcn_readfirstlane(F.tid >> 6);
                pg8::Gemm g{D, D, D}; pg8::PlainSched<WGM_GU> S{M / 256, 2 * FF / 256, F.G, F.bx, (const char*)H, (const char*)(ws + WS_WGU), (size_t)256 * D * 2, (size_t)256 * D * 2};
                pg8::EpiSwiGlu E{(bf16_t*)(ws + AR_HIDE), nullptr};
                pg8::gemm_phase<false>(F.lds, F.tid, g, S, E);
                xcd_barrier(bar); }
#endif
            PHASE_BEGIN(10)
#if defined(DENSE_F8) || defined(DENSE_DOWN_F8)
                pg8::Gemm g{FF / 2, FF / 2, FF / 2}; pg8::PlainSched<WGM_DOWN> S{M / 256, D / 256, F.G, F.bx, (const char*)(ws + AR_HIDE), (const char*)(ws + WS_WDN), (size_t)256 * FF, (size_t)256 * FF};
#if NORM_FOLD && STATS_FUSED
                pg8::EpiResB16S E{X, X, 1.0f / WSCALE8, (float*)(ws + WS_PART), (LAS float*)(F.lds + pg8::LDS_SS_OFF)};
#else
                pg8::EpiResB16<bf16_t> E{X, X, 1.0f / WSCALE8};
#endif
                pg8::gemm_phase<true>(F.lds, F.tid, g, S, E);
#else
                pg8::Gemm g{FF, FF, FF}; pg8::PlainSched<WGM_DOWN> S{M / 256, D / 256, F.G, F.bx, (const char*)(ws + AR_HIDE), (const char*)(ws + WS_WDN), (size_t)256 * FF * 2, (size_t)256 * FF * 2};
                pg8::EpiResB16<bf16_t> E{X, X, 1.0f};
                pg8::gemm_phase<false>(F.lds, F.tid, g, S, E);
#endif
            PHASE_END
        } else {
            PHASE_BEGIN(11)
                phase_moe_gather(F, args);
            PHASE_END
            PHASE_BEGIN(12)
                MoeSched<WGM_MOEGU, true> S; { const int* tpg = (const int*)(ws + WS_TP);
#pragma unroll
                    for (int e = 0; e < 9; ++e) S.tp[e] = __builtin_amdgcn_readfirstlane(tpg[e]); }
                S.nN = 2 * FF / 256; S.G = F.G; S.c = F.bx; S.A = (const char*)(ws + WS_H); S.B = (const char*)(ws + WS_WEGU); S.tA = (size_t)256 * D; S.tB = (size_t)256 * D; S.eB = SZ_WGU8; S.rowtok = (const int*)(ws + WS_ROWTOK);
                pg8::Gemm g{D / 2, D / 2, D / 2}; pg8::EpiSwiGluF8 E{ws + AR_HIDE, (const float*)(ws + WS_ROWGATE), 1.0f / WSCALE8};
                pg8::gemm_phase<true>(F.lds, F.tid, g, S, E);
            PHASE_END
            PHASE_BEGIN(13)
                MoeSched<WGM_MOEDN, false> S; { const int* tpg = (const int*)(ws + WS_TP);
#pragma unroll
                    for (int e = 0; e < 9; ++e) S.tp[e] = __builtin_amdgcn_readfirstlane(tpg[e]); }
                S.nN = D / 256; S.G = F.G; S.c = F.bx; S.A = (const char*)(ws + AR_HIDE); S.B = (const char*)(ws + WS_WEDN); S.tA = (size_t)256 * FF; S.tB = (size_t)256 * FF; S.eB = SZ_WDN8; S.rowtok = nullptr;
                pg8::Gemm g{FF / 2, FF / 2, FF / 2}; pg8::EpiMoeDown E{(const int*)(ws + WS_ROWTOK), X, (bf16_t*)(ws + AR_Y0), 1.0f / WSCALE8};
                pg8::gemm_phase<true>(F.lds, F.tid, g, S, E);
            PHASE_END
        }
    }
__global__ void __launch_bounds__(512, 2) hybrid_fwd(Args args_in) {
    extern __shared__ __attribute__((aligned(16))) unsigned char lds_raw[];
    KArgs* ka = (KArgs*)__builtin_amdgcn_kernarg_segment_ptr();
    Ctx F0; F0.lds = (LAS unsigned char*)lds_raw; F0.tid = threadIdx.x; F0.lane = F0.tid & 63; F0.wave = __builtin_amdgcn_readfirstlane(F0.tid >> 6);
    F0.G = gridDim.x; F0.bx = blockIdx.x; F0.vcu = (F0.G % 8 == 0) ? (F0.bx % 8) * (F0.G / 8) + F0.bx / 8 : F0.bx;
    volatile LAS unsigned* MISC = (volatile LAS unsigned*)(F0.lds + LDS_MISC);
    if (F0.tid < 64) MISC[F0.tid] = 0u;
    __syncthreads();
    XcdBarrier bar = xcd_barrier_post((unsigned*)(ka->ws + WS_CTL) + 1024, MISC + 8);
    const int lo = ka->ph_lo, hi = ka->ph_hi;
    int ph = 0;
    PHASE_BEGIN(0)
        p0_convert(F, args);
        __syncthreads(); RELAUNDER();
#if NORM_FOLD
        phase_x_bf16_stats(F, args.in[I_X], X, (float*)(ws + WS_RSTD));
#else
        phase_rmsnorm_bf16(F, args.in[I_X], args.in[I_ATTN_NORM], H);
#endif
    PHASE_END

    layer_phases<0>(F0, ka, bar, lo, hi, ph);
    layer_phases<1>(F0, ka, bar, lo, hi, ph);
    PHASE_BEGIN(14)
        phase_final_norm(F, X, (const bf16_t*)(ws + AR_Y0), args.in[I_FINAL_NORM], args.out);
    PHASE_END
#undef PHASE_BEGIN
#undef PHASE_END
#undef X
#undef H
#undef PROJ
#undef MIXED
}
constexpr int N_PHASES = 1 + 8 + 2 + 8 + 3 + 1;

#ifndef MK_PER_PHASE
#define MK_PER_PHASE 0
#endif
extern "C" void kernel_launch(void* const* d_in, const int* in_sizes, int n_in, void* d_out, int out_size, void* d_ws, size_t ws_size, hipStream_t stream) {
    static int grid = 0;
    if (grid == 0) {
        if (n_in != 24 || out_size != M * D || ws_size < WS_END) { fprintf(stderr, "kernel_launch: unexpected shapes (n_in %d out %d ws %zu need %zu)\n", n_in, out_size, ws_size, (size_t)WS_END); grid = -1; return; }
        int dev = 0, cus = 0, per_cu = 0;
        if (hipGetDevice(&dev) != hipSuccess || hipDeviceGetAttribute(&cus, hipDeviceAttributeMultiprocessorCount, dev) != hipSuccess) { grid = -1; return; }
        if (hipFuncSetAttribute((const void*)hybrid_fwd, hipFuncAttributeMaxDynamicSharedMemorySize, LDS_BYTES) != hipSuccess) { fprintf(stderr, "kernel_launch: hipFuncSetAttribute failed\n"); grid = -1; return; }
        if (hipOccupancyMaxActiveBlocksPerMultiprocessor(&per_cu, (const void*)hybrid_fwd, 512, LDS_BYTES) != hipSuccess || per_cu < 1) fprintf(stderr, "kernel_launch: occupancy query says %d\n", per_cu);
        (void)hipGetLastError();
        grid = cus < 256 ? cus : 256;
        if (grid != 256) fprintf(stderr, "kernel_launch: %d CUs; this kernel is written for 256\n", cus);
    }
    if (grid < 0) return;
    (void)hipMemsetAsync((char*)d_ws + WS_CTL, 0, CTL_ZERO_BYTES, stream);
    Args a{};
    for (int i = 0; i < 24; ++i) a.in[i] = (const float*)d_in[i];
    a.out = (float*)d_out; a.ws = (unsigned char*)d_ws;
#if MK_PER_PHASE
    for (int p = 0; p < N_PHASES; ++p) { a.ph_lo = p; a.ph_hi = p + 1; hipLaunchKernelGGL(hybrid_fwd, dim3(grid), dim3(512), LDS_BYTES, stream, a); }
#else
    a.ph_lo = 0; a.ph_hi = N_PHASES;
    hipLaunchKernelGGL(hybrid_fwd, dim3(grid), dim3(512), LDS_BYTES, stream, a);
#endif
}
```

```cpp
#include <hip/hip_runtime.h>
#if !defined(DENSE_DOWN_BF16) && !defined(DENSE_F8) && !defined(DENSE_DOWN_F8)
#define DENSE_DOWN_F8 1
#endif
#include <cstdio>
#include <cstdint>

#define LAS __attribute__((address_space(3)))
#define GAS __attribute__((address_space(1)))
typedef unsigned short bf16_t;
typedef short bf16x8 __attribute__((ext_vector_type(8)));
typedef short s16x4 __attribute__((ext_vector_type(4)));
typedef float f32x2 __attribute__((ext_vector_type(2)));
typedef float f32x4 __attribute__((ext_vector_type(4)));
typedef float f32x16 __attribute__((ext_vector_type(16)));
typedef unsigned u32x2 __attribute__((ext_vector_type(2)));
typedef unsigned u32x4 __attribute__((ext_vector_type(4)));

constexpr int NB = 4, T = 4096, M = NB * T, D = 2048, DIN = 5680, DINP = 5888, FF = 5632, NE = 8, DEPTH = 2;
constexpr int C_Z = 0, C_XBC = 512, C_NAQ = 1536, C_NAK = 2048, C_NAV = 2560, C_CQ = 3072, C_CKV = 3584, C_DLQ = 4096, C_DLK = 4608, C_DLV = 5120, C_KR = 5632, C_DT = 5664;
constexpr int HGROWS = 34816;
constexpr float NORM_EPS = 1e-6f;
constexpr float Y0SCALE = 16.0f;
constexpr float LOG2E = 1.4426950408889634f;

constexpr size_t MiB = 1u << 20;
constexpr size_t WS_CTL = 0, CTL_ZERO_BYTES = 1 * MiB;
constexpr size_t WS_ROPE = 1 * MiB;
constexpr size_t WS_ROUTE = 2 * MiB;
constexpr size_t WS_HISTO = 2 * MiB + 256 * 1024;
constexpr size_t WS_TP = WS_HISTO + 16 * 1024;
constexpr size_t WS_ROWTOK = 2 * MiB + 512 * 1024;
constexpr size_t WS_ROWGATE = 2 * MiB + 768 * 1024;
constexpr size_t WS_CDEC = 3 * MiB;
constexpr size_t WS_W = 4 * MiB;
constexpr size_t SZ_WIN = (size_t)DINP * D * 2, SZ_WO = (size_t)D * D * 2, SZ_WUQKV = (size_t)1792 * 512 * 2, SZ_WGU = (size_t)2 * FF * D * 2, SZ_WDN = (size_t)D * FF * 2;
constexpr size_t WS_WIN = WS_W, WS_WO = WS_WIN + 2 * SZ_WIN, WS_WUQKV = WS_WO + 2 * SZ_WO, WS_WGU = WS_WUQKV + 4 * MiB, WS_WDN = WS_WGU + SZ_WGU;
constexpr size_t SZ_WGU8 = SZ_WGU / 2, SZ_WDN8 = SZ_WDN / 2;
constexpr float WSCALE8 = 64.0f;
constexpr size_t WS_WEGU = WS_WDN + SZ_WDN, WS_WEDN = WS_WEGU + NE * SZ_WGU, WS_WEND = WS_WEDN + NE * SZ_WDN;
constexpr size_t WS_X = 664 * MiB, WS_H = 792 * MiB, WS_AR = 856 * MiB;
static_assert(WS_WEND <= WS_X, "weights overflow");
constexpr size_t AR_PROJ = WS_AR, AR_XBC = WS_AR + 184 * MiB, AR_DT = WS_AR + 216 * MiB, AR_CS = WS_AR + 217 * MiB, AR_ST = WS_AR + 218 * MiB, AR_PREV = WS_AR + 282 * MiB;
constexpr size_t AR_QMLA = WS_AR + 314 * MiB, AR_KV = WS_AR + 338 * MiB, AR_DILP = WS_AR + 370 * MiB, AR_DLSE = WS_AR + 418 * MiB, AR_MIXED = WS_AR + 420 * MiB;
constexpr size_t AR_HG = WS_AR, AR_Y0 = WS_AR, AR_HIDE = WS_AR + 136 * MiB;
constexpr size_t WS_END = WS_AR + 510 * MiB;
static_assert((size_t)M * DINP * 2 <= 184 * MiB && (size_t)HGROWS * D * 2 <= 136 * MiB && (size_t)HGROWS * FF * 2 <= 374 * MiB, "arena");

#ifndef NORM_FOLD
#define NORM_FOLD 1
#endif
constexpr size_t WS_PART = 3 * MiB + 512 * 1024;
#ifndef STATS_FUSED
#define STATS_FUSED 1
#endif
constexpr size_t WS_RSTD2 = 640 * 1024;
constexpr size_t WS_RSTD = 512 * 1024;
constexpr int LDS_BYTES = 159744;
constexpr int LDS_MISC = LDS_BYTES - 256;

__device__ __forceinline__ unsigned cvt_pk_bf16(float lo, float hi) { unsigned r; asm volatile("v_cvt_pk_bf16_f32 %0, %1, %2" : "=v"(r) : "v"(lo), "v"(hi)); return r; }
__device__ __forceinline__ float bf_lo(unsigned w) { return __uint_as_float(w << 16); }
__device__ __forceinline__ float bf_hi(unsigned w) { return __uint_as_float(w & 0xffff0000u); }
__device__ __forceinline__ float bf2f(bf16_t b) { return __uint_as_float(((unsigned)b) << 16); }
template <int O> __device__ __forceinline__ int swz_xor_i(int v) { return __builtin_amdgcn_ds_swizzle(v, (O << 10) | 0x1F); }
template <int O> __device__ __forceinline__ float swz_xor(float v) { return __int_as_float(__builtin_amdgcn_ds_swizzle(__float_as_int(v), (O << 10) | 0x1F)); }
__device__ __forceinline__ float xhalf_sum(float v) { auto rr = __builtin_amdgcn_permlane32_swap(__float_as_uint(v), __float_as_uint(v), false, false); return __uint_as_float(rr[0]) + __uint_as_float(rr[1]); }
__device__ __forceinline__ float xhalf_max(float v) { auto rr = __builtin_amdgcn_permlane32_swap(__float_as_uint(v), __float_as_uint(v), false, false); return fmaxf(__uint_as_float(rr[0]), __uint_as_float(rr[1])); }
__device__ __forceinline__ int xhalf_sum_i(int v) { auto rr = __builtin_amdgcn_permlane32_swap((unsigned)v, (unsigned)v, false, false); return (int)(rr[0] + rr[1]); }
__device__ __forceinline__ float wave_sum(float v) {
    v += swz_xor<1>(v); v += swz_xor<2>(v); v += swz_xor<4>(v); v += swz_xor<8>(v); v += swz_xor<16>(v);
    return xhalf_sum(v);
}
__device__ __forceinline__ int wave_sum_i(int v) {
    v += swz_xor_i<1>(v); v += swz_xor_i<2>(v); v += swz_xor_i<4>(v); v += swz_xor_i<8>(v); v += swz_xor_i<16>(v);
    return xhalf_sum_i(v);
}
__device__ __forceinline__ float silu_f(float x) { return x * __builtin_amdgcn_rcpf(1.0f + __builtin_amdgcn_exp2f(-1.4426950408889634f * x)); }
__device__ __forceinline__ int crow(int r, int hi) { return (r & 3) + 8 * (r >> 2) + 4 * hi; }
typedef short v4i16_t __attribute__((ext_vector_type(4)));
__device__ __forceinline__ s16x4 trr(LAS const char* p) { return __builtin_bit_cast(s16x4, __builtin_amdgcn_ds_read_tr16_b64_v4i16((LAS v4i16_t*)p)); }
__device__ __forceinline__ bf16x8 cat8(s16x4 lo, s16x4 hi) { return (bf16x8){lo[0], lo[1], lo[2], lo[3], hi[0], hi[1], hi[2], hi[3]}; }
#define LDS_WAIT() asm volatile("s_waitcnt lgkmcnt(0)" ::: "memory")
#define VM_WAIT() asm volatile("s_waitcnt vmcnt(0)" ::: "memory")

namespace pg8 {
constexpr int BM = 256, BK = 64, HALF = 128, HTB = HALF * BK * 2, STAGE_BYTES = 8 * HTB, NXCD = 8;
__host__ __device__ __forceinline__ int lds_byte(int r, int c) { const int st = (r >> 4) * 2 + (c >> 5), rr = r & 15, cc = c & 31, ob = rr * 64 + cc * 2; return st * 1024 + (ob ^ (((ob >> 9) & 1) << 5)); }
__host__ __device__ __forceinline__ void stage_rc(int b, int& R, int& C) { const int st = b / 1024, sb = b % 1024, swz = sb ^ (((sb >> 9) & 1) << 5); R = (st >> 1) * 16 + swz / 64; C = (st & 1) * 32 + (swz % 64) / 2; }
__host__ __device__ __forceinline__ int perm32(int rho) { const int n = rho >> 4, i = rho & 15; return 8 * (i >> 2) + 4 * n + (i & 3); }

typedef int i32x4 __attribute__((ext_vector_type(4)));
typedef int i32x8 __attribute__((ext_vector_type(8)));
__device__ __forceinline__ i32x8 cat_f8(bf16x8 lo, bf16x8 hi) { const i32x4 a = __builtin_bit_cast(i32x4, lo), b = __builtin_bit_cast(i32x4, hi); return __builtin_shufflevector(a, b, 0, 1, 2, 3, 4, 5, 6, 7); }
struct Unit { int pm, pn, e; const char* a; const char* b; };
struct Gemm { int lda, ldb, K; };

template <int WGMT>
__device__ __forceinline__ bool tile_of(int i, int G, int c, int nM, int nN, int& pm, int& pn) {
    constexpr int WGM = WGMT;
    const int nwg = nM * nN; const long L = (long)i * G + c; if (L >= nwg) return false;
    int wgid = (int)L; { const int q = nwg / NXCD, r = nwg % NXCD, xcd = wgid % NXCD, off = wgid / NXCD; wgid = (xcd < r ? xcd * (q + 1) : r * (q + 1) + (xcd - r) * q) + off; }
    const int nig = WGM * nN, gid = wgid / nig, fm = gid * WGM, gsz = (nM - fm) < WGM ? (nM - fm) : WGM;
    pm = fm + ((wgid % nig) % gsz); pn = (wgid % nig) / gsz; return true;
}
template <int WGMT>
struct PlainSched {
    static constexpr bool GATHER = false;
    int nM, nN, G, c; const char* A; const char* B; size_t tA, tB;
    __device__ __forceinline__ void gather(const Unit&, int, unsigned (&)[2][2]) const {}
    __device__ __forceinline__ bool next(int i, Unit& u) const { if (!tile_of<WGMT>(i, G, c, nM, nN, u.pm, u.pn)) return false; u.e = i  ; u.a = A + (size_t)u.pm * tA; u.b = B + (size_t)u.pn * tB; return true; }
};

template <bool F8, class Epi, class Sched>
__device__ __forceinline__ void gemm_phase(LAS unsigned char* lds, const int tid, const Gemm g, const Sched& S, const Epi& E) {
    const int wid = __builtin_amdgcn_readfirstlane(tid >> 6), lane = tid & 63, wr = wid >> 2, wc = wid & 3, fr = lane & 15, fq = lane >> 4;
    const int K = g.K, nt = K / BK;
    unsigned voffA[2], voffB[2];
#pragma unroll
    for (int i = 0; i < 2; ++i) { int R, C; stage_rc(tid * 16 + i * 8192, R, C); const int Rb = Epi::PERM ? ((R & ~31) + perm32(R & 31)) : R;
        voffA[i] = (unsigned)(R * g.lda + C) * 2u; voffB[i] = (unsigned)(Rb * g.ldb + C) * 2u; }
    const size_t kstep = (size_t)(BK * 2);
    const size_t hA = (size_t)HALF * g.lda * 2, hB = (size_t)HALF * g.ldb * 2;
    const unsigned ldsw = (unsigned)wid * 1024u;
    const int aoff = lds_byte(wr * 64 + fr, fq * 8), boff = lds_byte(wc * 32 + fr, fq * 8);
#define PG8_SA(b, h) (((b) * 2 + (h)) * HTB)
#define PG8_SB(b, h) ((4 + (b) * 2 + (h)) * HTB)
#define PG8_STAGE(bufoff, gbase, voff) do { _Pragma("unroll") for (int _i = 0; _i < 2; ++_i) \
        __builtin_amdgcn_global_load_lds((const unsigned*)((const char*)(gbase) + (voff)[_i]), (LAS unsigned*)(lds + (bufoff) + ldsw + _i * 8192), 16, 0, 0); } while (0)
#define PG8_STAGEA(bufoff, gptr, half, NX) do { if constexpr (Sched::GATHER) { _Pragma("unroll") for (int _i = 0; _i < 2; ++_i) { const unsigned _o = (NX) ? gAn[half][_i] : gAc[half][_i]; \
        __builtin_amdgcn_global_load_lds((const unsigned*)((const char*)(gptr) + _o), (LAS unsigned*)(lds + (bufoff) + ldsw + _i * 8192), 16, 0, 0); } } \
    else PG8_STAGE(bufoff, (const char*)(gptr) + ((half) ? hA : (size_t)0), voffA); } while (0)
#define PG8_LDA(dst, b, h) do { _Pragma("unroll") for (int m = 0; m < 4; ++m) { const i32x4 _x0 = *(const LAS i32x4*)(lds + PG8_SA(b, h) + aoff + m * 2048), _x1 = *(const LAS i32x4*)(lds + PG8_SA(b, h) + aoff + m * 2048 + 1024); dst[m] = __builtin_shufflevector(_x0, _x1, 0, 1, 2, 3, 4, 5, 6, 7); } } while (0)
#define PG8_LDB(dst, b, h) do { _Pragma("unroll") for (int n = 0; n < 2; ++n) { const i32x4 _x0 = *(const LAS i32x4*)(lds + PG8_SB(b, h) + boff + n * 2048), _x1 = *(const LAS i32x4*)(lds + PG8_SB(b, h) + boff + n * 2048 + 1024); dst[n] = __builtin_shufflevector(_x0, _x1, 0, 1, 2, 3, 4, 5, 6, 7); } } while (0)
#define PG8_K0(x) __builtin_bit_cast(bf16x8, __builtin_shufflevector(x, x, 0, 1, 2, 3))
#define PG8_K1(x) __builtin_bit_cast(bf16x8, __builtin_shufflevector(x, x, 4, 5, 6, 7))
#define PG8_MMA(ai, bj, At, Bt) do { __builtin_amdgcn_s_setprio(1); _Pragma("unroll") for (int m = 0; m < 4; ++m) _Pragma("unroll") for (int n = 0; n < 2; ++n) { \
        if constexpr (F8) { asm volatile("v_mfma_scale_f32_16x16x128_f8f6f4 %0, %1, %2, %0, %3, %3 op_sel_hi:[0,0,0]" : "+v"(acc[ai][bj][m][n]) : "v"(Bt[n]), "v"(At[m]), "v"(sc8)); } \
        else { acc[ai][bj][m][n] = __builtin_amdgcn_mfma_f32_16x16x32_bf16(PG8_K0(Bt[n]), PG8_K0(At[m]), acc[ai][bj][m][n], 0, 0, 0); \
               acc[ai][bj][m][n] = __builtin_amdgcn_mfma_f32_16x16x32_bf16(PG8_K1(Bt[n]), PG8_K1(At[m]), acc[ai][bj][m][n], 0, 0, 0); } } __builtin_amdgcn_s_setprio(0); } while (0)
#define PG8_WAIT_V(n) asm volatile("s_waitcnt vmcnt(" #n ")" ::: "memory")
#define PG8_WAIT_L(n) asm volatile("s_waitcnt lgkmcnt(" #n ")" ::: "memory")
#define PG8_BAR __builtin_amdgcn_s_barrier()
#define PG8_SCHED __builtin_amdgcn_sched_barrier(0)
    Unit cur, nxt; int ui = 0;
    if (!S.next(0, cur)) return;
    f32x4 acc[2][2][4][2];
#pragma unroll
    for (int a = 0; a < 2; ++a)
#pragma unroll
        for (int b = 0; b < 2; ++b)
#pragma unroll
            for (int m = 0; m < 4; ++m)
#pragma unroll
                for (int n = 0; n < 2; ++n) acc[a][b][m][n] = (f32x4){0.f, 0.f, 0.f, 0.f};
    i32x8 At[4], B0[2], B1[2];
    int sc8 = 0x7F7F7F7F; asm volatile("" : "+v"(sc8));
    const char* cA = cur.a; const char* cB = cur.b;
    unsigned gAc[2][2] = {{0u, 0u}, {0u, 0u}}, gAn[2][2] = {{0u, 0u}, {0u, 0u}};
    if constexpr (Sched::GATHER) S.gather(cur, tid, gAc);
    PG8_STAGE(PG8_SB(0, 0), cB, voffB); PG8_STAGE(PG8_SB(0, 1), cB + hB, voffB); PG8_STAGEA(PG8_SA(0, 0), cA, 0, false); PG8_STAGEA(PG8_SA(0, 1), cA, 1, false);
    if (wr == 1) PG8_BAR;
    PG8_WAIT_V(2); PG8_BAR;
    PG8_STAGE(PG8_SB(1, 0), cB + kstep, voffB); PG8_STAGEA(PG8_SA(1, 0), cA + kstep, 0, false); PG8_STAGE(PG8_SB(1, 1), cB + hB + kstep, voffB);
    PG8_WAIT_V(6); PG8_BAR;
    for (;;) {
        const bool has_next = S.next(ui + 1, nxt);
        if constexpr (Sched::GATHER) { if (has_next) S.gather(nxt, tid, gAn); else { gAn[0][0] = gAc[0][0]; gAn[0][1] = gAc[0][1]; gAn[1][0] = gAc[1][0]; gAn[1][1] = gAc[1][1]; } }
        const char* nA = has_next ? nxt.a : cA; const char* nB = has_next ? nxt.b : cB;
#pragma unroll 1
        for (int t = 0; t < nt; t += 2) {
            const bool last = (t == nt - 2);
            const char* a1 = cA + (size_t)(t + 1) * kstep;
            const char* a2 = last ? nA : cA + (size_t)(t + 2) * kstep; const char* b2 = last ? nB : cB + (size_t)(t + 2) * kstep;
            const char* a3 = a2 + kstep; const char* b3 = b2 + kstep;
            PG8_LDB(B0, 0, 0); PG8_LDB(B1, 0, 1); PG8_SCHED; PG8_LDA(At, 0, 0); PG8_STAGEA(PG8_SA(1, 1), a1, 1, false);
            PG8_WAIT_V(8); PG8_WAIT_L(0); PG8_BAR; PG8_MMA(0, 0, At, B0); PG8_MMA(0, 1, At, B1); PG8_BAR; PG8_SCHED;
            PG8_LDA(At, 0, 1); PG8_STAGE(PG8_SB(0, 0), b2, voffB); PG8_STAGE(PG8_SB(0, 1), b2 + hB, voffB); PG8_STAGEA(PG8_SA(0, 0), a2, 0, last);
            PG8_WAIT_V(8); PG8_WAIT_L(0); PG8_BAR; PG8_MMA(1, 0, At, B0); PG8_MMA(1, 1, At, B1); PG8_BAR; PG8_SCHED;
            PG8_LDB(B0, 1, 0); PG8_LDB(B1, 1, 1); PG8_SCHED; PG8_LDA(At, 1, 0); PG8_STAGEA(PG8_SA(0, 1), a2, 1, last);
            PG8_WAIT_V(8); PG8_WAIT_L(0); PG8_BAR; PG8_MMA(0, 0, At, B0); PG8_MMA(0, 1, At, B1); PG8_BAR; PG8_SCHED;
            PG8_LDA(At, 1, 1); PG8_STAGE(PG8_SB(1, 0), b3, voffB); PG8_STAGE(PG8_SB(1, 1), b3 + hB, voffB); PG8_STAGEA(PG8_SA(1, 0), a3, 0, last);
            PG8_WAIT_V(8); PG8_WAIT_L(0); PG8_BAR; PG8_MMA(1, 0, At, B0); PG8_MMA(1, 1, At, B1); PG8_BAR; PG8_SCHED;
        }
        if constexpr (F8) asm volatile("s_nop 15\n\ts_nop 15" ::: "memory");
#ifndef NO_ALIGN_EPI
        if (wr == 0) PG8_BAR;
#endif
        E(acc, cur, wr, wc, fr, fq);
        if (!has_next) break;
#pragma unroll
        for (int a = 0; a < 2; ++a)
#pragma unroll
            for (int b = 0; b < 2; ++b)
#pragma unroll
                for (int m = 0; m < 4; ++m)
#pragma unroll
                    for (int n = 0; n < 2; ++n) acc[a][b][m][n] = (f32x4){0.f, 0.f, 0.f, 0.f};
        cur = nxt; cA = nA; cB = nB; ++ui;
        if constexpr (Sched::GATHER) { gAc[0][0] = gAn[0][0]; gAc[0][1] = gAn[0][1]; gAc[1][0] = gAn[1][0]; gAc[1][1] = gAn[1][1]; }
#ifndef NO_ALIGN_EPI
        if (wr == 1) PG8_BAR;
#endif
    }
    PG8_WAIT_V(0);
#ifdef NO_ALIGN_EPI
    if (wr == 0) PG8_BAR;
#endif
    PG8_BAR;
#undef PG8_SA
#undef PG8_SB
#undef PG8_STAGE
#undef PG8_STAGEA
#undef PG8_LDA
#undef PG8_LDB
#undef PG8_MMA
#undef PG8_K0
#undef PG8_K1
#undef PG8_WAIT_V
#undef PG8_WAIT_L
#undef PG8_BAR
#undef PG8_SCHED
}

struct EpiBf16 {
    static constexpr bool PERM = true;
    bf16_t* O; int ldc;
    __device__ __forceinline__ void operator()(const f32x4 (&acc)[2][2][4][2], const Unit& u, int wr, int wc, int fr, int fq) const {
        const int row0 = u.pm * BM + wr * 64 + fr, col0 = u.pn * BM + wc * 32 + 8 * fq;
#pragma unroll
        for (int ai = 0; ai < 2; ++ai)
#pragma unroll
            for (int m = 0; m < 4; ++m) { bf16_t* rowp = O + (size_t)(row0 + ai * HALF + m * 16) * ldc + col0;
#pragma unroll
                for (int bj = 0; bj < 2; ++bj) { const f32x4 v0 = acc[ai][bj][m][0], v1 = acc[ai][bj][m][1];
                    u32x4 w; w.x = cvt_pk_bf16(v0[0], v0[1]); w.y = cvt_pk_bf16(v0[2], v0[3]); w.z = cvt_pk_bf16(v1[0], v1[1]); w.w = cvt_pk_bf16(v1[2], v1[3]);
                    *(u32x4*)(rowp + bj * HALF) = w; } }
    }
};
struct EpiBf16R {
    static constexpr bool PERM = true;
    bf16_t* O; int ldc; const float* rs;
    __device__ __forceinline__ void operator()(const f32x4 (&acc)[2][2][4][2], const Unit& u, int wr, int wc, int fr, int fq) const {
        const int row0 = u.pm * BM + wr * 64 + fr, col0 = u.pn * BM + wc * 32 + 8 * fq;
        float rv[2][4];
#pragma unroll
        for (int ai = 0; ai < 2; ++ai)
#pragma unroll
            for (int m = 0; m < 4; ++m) rv[ai][m] = rs[row0 + ai * HALF + m * 16];
        asm volatile("" ::: "memory");
#pragma unroll
        for (int ai = 0; ai < 2; ++ai)
#pragma unroll
            for (int m = 0; m < 4; ++m) { bf16_t* rowp = O + (size_t)(row0 + ai * HALF + m * 16) * ldc + col0; const float r = rv[ai][m];
#pragma unroll
                for (int bj = 0; bj < 2; ++bj) { const f32x4 v0 = acc[ai][bj][m][0] * r, v1 = acc[ai][bj][m][1] * r;
                    u32x4 w; w.x = cvt_pk_bf16(v0[0], v0[1]); w.y = cvt_pk_bf16(v0[2], v0[3]); w.z = cvt_pk_bf16(v1[0], v1[1]); w.w = cvt_pk_bf16(v1[2], v1[3]);
                    *(u32x4*)(rowp + bj * HALF) = w; } }
    }
};
struct EpiBf16R2 {
    static constexpr bool PERM = true;
    bf16_t* O; int ldc; const float* rs2;
    __device__ __forceinline__ void operator()(const f32x4 (&acc)[2][2][4][2], const Unit& u, int wr, int wc, int fr, int fq) const {
        const int row0 = u.pm * BM + wr * 64 + fr, col0 = u.pn * BM + wc * 32 + 8 * fq, sel = u.pn >= 3 ? 1 : 0;
        float rv[2][4];
#pragma unroll
        for (int ai = 0; ai < 2; ++ai)
#pragma unroll
            for (int m = 0; m < 4; ++m) rv[ai][m] = rs2[(size_t)(row0 + ai * HALF + m * 16) * 2 + sel];
        asm volatile("" ::: "memory");
#pragma unroll
        for (int ai = 0; ai < 2; ++ai)
#pragma unroll
            for (int m = 0; m < 4; ++m) { bf16_t* rowp = O + (size_t)(row0 + ai * HALF + m * 16) * ldc + col0; const float r = rv[ai][m];
#pragma unroll
                for (int bj = 0; bj < 2; ++bj) { const f32x4 v0 = acc[ai][bj][m][0] * r, v1 = acc[ai][bj][m][1] * r;
                    u32x4 w; w.x = cvt_pk_bf16(v0[0], v0[1]); w.y = cvt_pk_bf16(v0[2], v0[3]); w.z = cvt_pk_bf16(v1[0], v1[1]); w.w = cvt_pk_bf16(v1[2], v1[3]);
                    *(u32x4*)(rowp + bj * HALF) = w; } }
    }
};
struct EpiMla {
    static constexpr bool PERM = true;
    bf16_t* Q; bf16_t* KV;
    __device__ __forceinline__ void operator()(const f32x4 (&acc)[2][2][4][2], const Unit& u, int wr, int wc, int fr, int fq) const {
        const bool isq = u.pn < 3; bf16_t* O = isq ? Q : KV; const int ldc = isq ? 768 : 1024; const int pn = isq ? u.pn : u.pn - 3;
        const int row0 = u.pm * BM + wr * 64 + fr, col0 = pn * BM + wc * 32 + 8 * fq;
#pragma unroll
        for (int ai = 0; ai < 2; ++ai)
#pragma unroll
            for (int m = 0; m < 4; ++m) { bf16_t* rowp = O + (size_t)(row0 + ai * HALF + m * 16) * ldc + col0;
#pragma unroll
                for (int bj = 0; bj < 2; ++bj) { const f32x4 v0 = acc[ai][bj][m][0], v1 = acc[ai][bj][m][1];
                    u32x4 w; w.x = cvt_pk_bf16(v0[0], v0[1]); w.y = cvt_pk_bf16(v0[2], v0[3]); w.z = cvt_pk_bf16(v1[0], v1[1]); w.w = cvt_pk_bf16(v1[2], v1[3]);
                    *(u32x4*)(rowp + bj * HALF) = w; } }
    }
};
#ifndef EPI_RB
#define EPI_RB 2
#endif
struct EpiResF32 {
    static constexpr bool PERM = false;
    const float* base; float* out; float scale;
    __device__ __forceinline__ void operator()(const f32x4 (&acc)[2][2][4][2], const Unit& u, int wr, int wc, int fr, int fq) const {
        const int row0 = u.pm * BM + wr * 64 + fr, col0 = u.pn * BM + wc * 32 + 4 * fq;
#pragma unroll
        for (int ai = 0; ai < 2; ++ai)
#pragma unroll
            for (int m0 = 0; m0 < 4; m0 += EPI_RB) { f32x4 bs[EPI_RB][2][2];
#pragma unroll
                for (int mi = 0; mi < EPI_RB; ++mi) { const size_t off = (size_t)(row0 + ai * HALF + (m0 + mi) * 16) * D + col0;
#pragma unroll
                    for (int bj = 0; bj < 2; ++bj)
#pragma unroll
                        for (int n = 0; n < 2; ++n) bs[mi][bj][n] = *(const f32x4*)(base + off + bj * HALF + n * 16); }
                asm volatile("" ::: "memory");
#pragma unroll
                for (int mi = 0; mi < EPI_RB; ++mi) { const size_t off = (size_t)(row0 + ai * HALF + (m0 + mi) * 16) * D + col0;
#pragma unroll
                    for (int bj = 0; bj < 2; ++bj)
#pragma unroll
                        for (int n = 0; n < 2; ++n) *(f32x4*)(out + off + bj * HALF + n * 16) = bs[mi][bj][n] + acc[ai][bj][m0 + mi][n] * scale; }
                asm volatile("" ::: "memory"); }
    }
};
template <class BT>
struct EpiResB16 {
    static constexpr bool PERM = true;
    const BT* base; bf16_t* out; float scale;
    __device__ __forceinline__ void operator()(const f32x4 (&acc)[2][2][4][2], const Unit& u, int wr, int wc, int fr, int fq) const {
        const int row0 = u.pm * BM + wr * 64 + fr, col0 = u.pn * BM + wc * 32 + 8 * fq;
#pragma unroll
        for (int ai = 0; ai < 2; ++ai)
#pragma unroll
            for (int m0 = 0; m0 < 4; m0 += EPI_RB) { f32x4 bs[EPI_RB][2][2];
#pragma unroll
                for (int mi = 0; mi < EPI_RB; ++mi) { const size_t off = (size_t)(row0 + ai * HALF + (m0 + mi) * 16) * D + col0;
#pragma unroll
                    for (int bj = 0; bj < 2; ++bj) {
                        if constexpr (sizeof(BT) == 4) { bs[mi][bj][0] = *(const f32x4*)((const float*)base + off + bj * HALF); bs[mi][bj][1] = *(const f32x4*)((const float*)base + off + bj * HALF + 4); }
                        else { const u32x4 x = *(const u32x4*)((const bf16_t*)base + off + bj * HALF); bs[mi][bj][0] = (f32x4){bf_lo(x.x), bf_hi(x.x), bf_lo(x.y), bf_hi(x.y)}; bs[mi][bj][1] = (f32x4){bf_lo(x.z), bf_hi(x.z), bf_lo(x.w), bf_hi(x.w)}; } } }
                asm volatile("" ::: "memory");
#pragma unroll
                for (int mi = 0; mi < EPI_RB; ++mi) { const size_t off = (size_t)(row0 + ai * HALF + (m0 + mi) * 16) * D + col0;
#pragma unroll
                    for (int bj = 0; bj < 2; ++bj) { const f32x4 v0 = bs[mi][bj][0] + acc[ai][bj][m0 + mi][0] * scale, v1 = bs[mi][bj][1] + acc[ai][bj][m0 + mi][1] * scale;
                        u32x4 w; w.x = cvt_pk_bf16(v0[0], v0[1]); w.y = cvt_pk_bf16(v0[2], v0[3]); w.z = cvt_pk_bf16(v1[0], v1[1]); w.w = cvt_pk_bf16(v1[2], v1[3]);
                        *(u32x4*)(out + off + bj * HALF) = w; } }
                asm volatile("" ::: "memory"); }
    }
};
constexpr int LDS_SS_OFF = 131072, LDS_LRS_OFF = 131072 + 4096;
struct EpiResB16S {
    static constexpr bool PERM = true;
    const bf16_t* base; bf16_t* out; float scale; float* part; LAS float* lss;
    __device__ __forceinline__ void operator()(const f32x4 (&acc)[2][2][4][2], const Unit& u, int wr, int wc, int fr, int fq) const {
        const int row0 = u.pm * BM + wr * 64 + fr, col0 = u.pn * BM + wc * 32 + 8 * fq;
        float ssr[2][4];
#pragma unroll
        for (int ai = 0; ai < 2; ++ai)
#pragma unroll
            for (int m = 0; m < 4; ++m) ssr[ai][m] = 0.f;
#pragma unroll
        for (int ai = 0; ai < 2; ++ai)
#pragma unroll
            for (int m0 = 0; m0 < 4; m0 += EPI_RB) { f32x4 bs[EPI_RB][2][2];
#pragma unroll
                for (int mi = 0; mi < EPI_RB; ++mi) { const size_t off = (size_t)(row0 + ai * HALF + (m0 + mi) * 16) * D + col0;
#pragma unroll
                    for (int bj = 0; bj < 2; ++bj) { const u32x4 x = *(const u32x4*)(base + off + bj * HALF); bs[mi][bj][0] = (f32x4){bf_lo(x.x), bf_hi(x.x), bf_lo(x.y), bf_hi(x.y)}; bs[mi][bj][1] = (f32x4){bf_lo(x.z), bf_hi(x.z), bf_lo(x.w), bf_hi(x.w)}; } }
                asm volatile("" ::: "memory");
#pragma unroll
                for (int mi = 0; mi < EPI_RB; ++mi) { const size_t off = (size_t)(row0 + ai * HALF + (m0 + mi) * 16) * D + col0; float ss = 0.f;
#pragma unroll
                    for (int bj = 0; bj < 2; ++bj) { const f32x4 v0 = bs[mi][bj][0] + acc[ai][bj][m0 + mi][0] * scale, v1 = bs[mi][bj][1] + acc[ai][bj][m0 + mi][1] * scale;
                        u32x4 w; w.x = cvt_pk_bf16(v0[0], v0[1]); w.y = cvt_pk_bf16(v0[2], v0[3]); w.z = cvt_pk_bf16(v1[0], v1[1]); w.w = cvt_pk_bf16(v1[2], v1[3]);
                        *(u32x4*)(out + off + bj * HALF) = w;
                        const unsigned ws4[4] = {w.x, w.y, w.z, w.w};
#pragma unroll
                        for (int q = 0; q < 4; ++q) { const float a0 = bf_lo(ws4[q]), a1 = bf_hi(ws4[q]); ss += a0 * a0 + a1 * a1; } }
                    ssr[ai][m0 + mi] = ss; }
                asm volatile("" ::: "memory"); }
#pragma unroll
        for (int ai = 0; ai < 2; ++ai)
#pragma unroll
            for (int m = 0; m < 4; ++m) { float t = ssr[ai][m]; t += swz_xor<16>(t); t = xhalf_sum(t); if (fq == 0) lss[wc * 256 + wr * 64 + fr + ai * HALF + m * 16] = t; }
        asm volatile("s_waitcnt lgkmcnt(0)" ::: "memory");
        __builtin_amdgcn_s_barrier();
        const int t = (wr * 4 + wc) * 64 + fq * 16 + fr;
        if (t < 256) part[(size_t)(u.pm * BM + t) * 8 + u.pn] = (lss[t] + lss[256 + t]) + (lss[512 + t] + lss[768 + t]);
    }
};
template <class Sched>
__device__ __forceinline__ void fill_lrs(const Sched& S, const float* part, LAS unsigned char* lds, int tid, int max_units) {
    LAS float* lrs = (LAS float*)(lds + LDS_LRS_OFF);
    for (int u0 = 0; u0 < max_units; u0 += 6) {
        f32x4 a[6], b[6]; bool ok[6];
#pragma unroll
        for (int j = 0; j < 6; ++j) { Unit u; ok[j] = (u0 + j < max_units) && S.next(u0 + j, u); a[j] = (f32x4){0.f, 0.f, 0.f, 0.f}; b[j] = a[j];
            if (ok[j] && tid < 256) { const f32x4* p = (const f32x4*)(part + (size_t)(u.pm * BM + tid) * 8); a[j] = p[0]; b[j] = p[1]; } }
#pragma unroll
        for (int j = 0; j < 6; ++j) if (ok[j] && tid < 256) { const float ss = ((a[j].x + a[j].y) + (a[j].z + a[j].w)) + ((b[j].x + b[j].y) + (b[j].z + b[j].w)); lrs[(u0 + j) * 256 + tid] = 1.0f / sqrtf(ss * (1.0f / D) + NORM_EPS); }
        if (!ok[5]) break; }
    __syncthreads();
}
struct EpiBf16RL {
    static constexpr bool PERM = true;
    bf16_t* O; int ldc; LAS const float* lrs;
    __device__ __forceinline__ void operator()(const f32x4 (&acc)[2][2][4][2], const Unit& u, int wr, int wc, int fr, int fq) const {
        const int row0 = u.pm * BM + wr * 64 + fr, col0 = u.pn * BM + wc * 32 + 8 * fq;
#pragma unroll
        for (int ai = 0; ai < 2; ++ai)
#pragma unroll
            for (int m = 0; m < 4; ++m) { bf16_t* rowp = O + (size_t)(row0 + ai * HALF + m * 16) * ldc + col0; const float r = lrs[u.e * 256 + wr * 64 + fr + ai * HALF + m * 16];
#pragma unroll
                for (int bj = 0; bj < 2; ++bj) { const f32x4 v0 = acc[ai][bj][m][0] * r, v1 = acc[ai][bj][m][1] * r;
                    u32x4 w; w.x = cvt_pk_bf16(v0[0], v0[1]); w.y = cvt_pk_bf16(v0[2], v0[3]); w.z = cvt_pk_bf16(v1[0], v1[1]); w.w = cvt_pk_bf16(v1[2], v1[3]);
                    *(u32x4*)(rowp + bj * HALF) = w; } }
    }
};
struct EpiSwiGlu {
    static constexpr bool PERM = true;
    bf16_t* H; const float* rowgate;
    __device__ __forceinline__ void operator()(const f32x4 (&acc)[2][2][4][2], const Unit& u, int wr, int wc, int fr, int fq) const {
        const int row0 = u.pm * BM + wr * 64 + fr, col0 = u.pn * HALF + wc * 32 + 8 * fq;
#pragma unroll
        for (int ai = 0; ai < 2; ++ai)
#pragma unroll
            for (int m = 0; m < 4; ++m) { const int row = row0 + ai * HALF + m * 16; const float rg = rowgate ? rowgate[row] : 1.0f;
                float o[8];
#pragma unroll
                for (int n = 0; n < 2; ++n)
#pragma unroll
                    for (int j = 0; j < 4; ++j) { const float gg = acc[ai][0][m][n][j], uu = acc[ai][1][m][n][j]; o[4 * n + j] = rg * silu_f(gg) * uu; }
                u32x4 w; w.x = cvt_pk_bf16(o[0], o[1]); w.y = cvt_pk_bf16(o[2], o[3]); w.z = cvt_pk_bf16(o[4], o[5]); w.w = cvt_pk_bf16(o[6], o[7]);
                *(u32x4*)(H + (size_t)row * FF + col0) = w; }
    }
};
__device__ __forceinline__ unsigned pk_fp8x4(float a, float b, float c, float d) { int w = __builtin_amdgcn_cvt_pk_fp8_f32(a, b, 0, false); w = __builtin_amdgcn_cvt_pk_fp8_f32(c, d, w, true); return (unsigned)w; }
struct EpiSwiGluF8 {
    static constexpr bool PERM = true;
    unsigned char* H; const float* rowgate; float inv;
    __device__ __forceinline__ void operator()(const f32x4 (&acc)[2][2][4][2], const Unit& u, int wr, int wc, int fr, int fq) const {
        const int row0 = u.pm * BM + wr * 64 + fr, col0 = u.pn * HALF + wc * 32 + 8 * fq;
        float rgv[2][4];
#pragma unroll
        for (int ai = 0; ai < 2; ++ai)
#pragma unroll
            for (int m = 0; m < 4; ++m) rgv[ai][m] = rowgate ? rowgate[row0 + ai * HALF + m * 16] : 1.0f;
        asm volatile("" ::: "memory");
#pragma unroll
        for (int ai = 0; ai < 2; ++ai)
#pragma unroll
            for (int m = 0; m < 4; ++m) { const int row = row0 + ai * HALF + m * 16; const float rg = rgv[ai][m] * inv;
                float o[8];
#pragma unroll
                for (int n = 0; n < 2; ++n)
#pragma unroll
                    for (int j = 0; j < 4; ++j) { const float gg = acc[ai][0][m][n][j] * inv, uu = acc[ai][1][m][n][j]; o[4 * n + j] = rg * silu_f(gg) * uu; }
                *(u32x2*)(H + (size_t)row * FF + col0) = (u32x2){pk_fp8x4(o[0], o[1], o[2], o[3]), pk_fp8x4(o[4], o[5], o[6], o[7])}; }
    }
};
struct EpiSwiGluF8R {
    static constexpr bool PERM = true;
    unsigned char* H; const float* rs;
    __device__ __forceinline__ void operator()(const f32x4 (&acc)[2][2][4][2], const Unit& u, int wr, int wc, int fr, int fq) const {
        const int row0 = u.pm * BM + wr * 64 + fr, col0 = u.pn * HALF + wc * 32 + 8 * fq;
        float rv[2][4];
#pragma unroll
        for (int ai = 0; ai < 2; ++ai)
#pragma unroll
            for (int m = 0; m < 4; ++m) rv[ai][m] = rs[row0 + ai * HALF + m * 16];
        asm volatile("" ::: "memory");
#pragma unroll
        for (int ai = 0; ai < 2; ++ai)
#pragma unroll
            for (int m = 0; m < 4; ++m) { const int row = row0 + ai * HALF + m * 16; const float r = rv[ai][m];
                float o[8];
#pragma unroll
                for (int n = 0; n < 2; ++n)
#pragma unroll
                    for (int j = 0; j < 4; ++j) { const float gg = acc[ai][0][m][n][j] * r, uu = acc[ai][1][m][n][j] * r; o[4 * n + j] = silu_f(gg) * uu; }
                *(u32x2*)(H + (size_t)row * FF + col0) = (u32x2){pk_fp8x4(o[0], o[1], o[2], o[3]), pk_fp8x4(o[4], o[5], o[6], o[7])}; }
    }
};
struct EpiSwiGluF8RL {
    static constexpr bool PERM = true;
    unsigned char* H; LAS const float* lrs;
    __device__ __forceinline__ void operator()(const f32x4 (&acc)[2][2][4][2], const Unit& u, int wr, int wc, int fr, int fq) const {
        const int row0 = u.pm * BM + wr * 64 + fr, col0 = u.pn * HALF + wc * 32 + 8 * fq;
#pragma unroll
        for (int ai = 0; ai < 2; ++ai)
#pragma unroll
            for (int m = 0; m < 4; ++m) { const int row = row0 + ai * HALF + m * 16; const float r = lrs[u.e * 256 + wr * 64 + fr + ai * HALF + m * 16];
                float o[8];
#pragma unroll
                for (int n = 0; n < 2; ++n)
#pragma unroll
                    for (int j = 0; j < 4; ++j) { const float gg = acc[ai][0][m][n][j] * r, uu = acc[ai][1][m][n][j] * r; o[4 * n + j] = silu_f(gg) * uu; }
                *(u32x2*)(H + (size_t)row * FF + col0) = (u32x2){pk_fp8x4(o[0], o[1], o[2], o[3]), pk_fp8x4(o[4], o[5], o[6], o[7])}; }
    }
};
struct EpiMoeDown {
    static constexpr bool PERM = true;
    const int* rowtok; bf16_t* X; bf16_t* Y0; float scale;
    __device__ __forceinline__ void operator()(const f32x4 (&acc)[2][2][4][2], const Unit& u, int wr, int wc, int fr, int fq) const {
        const int row0 = u.pm * BM + wr * 64 + fr, col0 = u.pn * BM + wc * 32 + 8 * fq;
        int rtv[2][4];
#pragma unroll
        for (int ai = 0; ai < 2; ++ai)
#pragma unroll
            for (int m = 0; m < 4; ++m) rtv[ai][m] = rowtok[row0 + ai * HALF + m * 16];
        asm volatile("" ::: "memory");
#pragma unroll
        for (int ai = 0; ai < 2; ++ai)
#pragma unroll
            for (int m = 0; m < 4; ++m) { const int rt = rtv[ai][m];
                if (rt >= 0) { const bool second = rt >= M; const int tok = second ? rt - M : rt;
                    if (second) { bf16_t* dst = X + (size_t)tok * D + col0; u32x4 bs[2];
#pragma unroll
                        for (int bj = 0; bj < 2; ++bj) bs[bj] = *(const u32x4*)(dst + bj * HALF);
                        asm volatile("" ::: "memory");
#pragma unroll
                        for (int bj = 0; bj < 2; ++bj) { const u32x4 x = bs[bj]; const f32x4 v0 = acc[ai][bj][m][0] * scale + (f32x4){bf_lo(x.x), bf_hi(x.x), bf_lo(x.y), bf_hi(x.y)}, v1 = acc[ai][bj][m][1] * scale + (f32x4){bf_lo(x.z), bf_hi(x.z), bf_lo(x.w), bf_hi(x.w)};
                            u32x4 w; w.x = cvt_pk_bf16(v0[0], v0[1]); w.y = cvt_pk_bf16(v0[2], v0[3]); w.z = cvt_pk_bf16(v1[0], v1[1]); w.w = cvt_pk_bf16(v1[2], v1[3]);
                            *(u32x4*)(dst + bj * HALF) = w; } }
                    else { unsigned char* dst = (unsigned char*)Y0 + (size_t)tok * D + col0;
                        const float s8 = scale * Y0SCALE;
#pragma unroll
                        for (int bj = 0; bj < 2; ++bj) { const f32x4 v0 = acc[ai][bj][m][0] * s8, v1 = acc[ai][bj][m][1] * s8;
                            *(u32x2*)(dst + bj * HALF) = (u32x2){pk_fp8x4(v0[0], v0[1], v0[2], v0[3]), pk_fp8x4(v1[0], v1[1], v1[2], v1[3])}; } } } }
    }
};
}

#define XB_TMO      128
#define XB_XCNT(j)  (256  + 64 * (j))
#define XB_XSUB(j)  (1280 + 64 * (j))
#define XB_XGEN(j)  (2304 + 64 * (j))
#define XB_TOP      3328
#define XB_TOPGEN   3392
#define XCD_BAR_WORDS 3456
#define XB_SPIN_CAP (1u << 22)
__device__ __forceinline__ unsigned xb_ld(unsigned* p)              { return __hip_atomic_load(p, __ATOMIC_RELAXED, __HIP_MEMORY_SCOPE_AGENT); }
__device__ __forceinline__ unsigned xb_add(unsigned* p, unsigned v) { return __hip_atomic_fetch_add(p, v, __ATOMIC_RELAXED, __HIP_MEMORY_SCOPE_AGENT); }
__device__ __forceinline__ unsigned xb_xcc_id() { return (unsigned)__builtin_amdgcn_s_getreg((3 << 11) | 20) & 0xFu; }
#define XB_SPIN(cond, bar) do { unsigned _sp = 0; while (cond) { __builtin_amdgcn_s_sleep(1); \
    if ((++_sp & 255u) == 0u) { if (xb_ld(&(bar)[XB_TMO])) break; if (_sp > XB_SPIN_CAP) { atomicAdd(&(bar)[XB_TMO], 1u); break; } } } } while (0)
struct XcdBarrier { unsigned* bar; unsigned x; volatile LAS unsigned* st; };
__device__ __forceinline__ XcdBarrier xcd_barrier_post(unsigned* bar, volatile LAS unsigned* st) {
    XcdBarrier b; b.bar = bar; b.x = xb_xcc_id(); b.st = st;
    if (threadIdx.x == 0) (void)xb_add(&bar[XB_XCNT(b.x)], 1u);
    return b;
}
__device__ __forceinline__ void xcd_barrier_complete(unsigned* bar, unsigned x, unsigned& nloc, unsigned& nx) {
    const unsigned G = gridDim.x * gridDim.y * gridDim.z;
    unsigned sum, cnt, mine, sp = 0u;
    for (;;) {
        sum = 0u; cnt = 0u; mine = 0u;
#pragma unroll
        for (unsigned j = 0; j < 16; ++j) { const unsigned c = xb_ld(&bar[XB_XCNT(j)]); sum += c; cnt += (c > 0u) ? 1u : 0u; mine = (j == x) ? c : mine; }
        if (sum == G) break;
        __builtin_amdgcn_s_sleep(1);
        if ((++sp & 255u) == 0u) { if (xb_ld(&bar[XB_TMO])) break; if (sp > XB_SPIN_CAP) { atomicAdd(&bar[XB_TMO], 1u); break; } }
    }
    nloc = mine > 0u ? mine : 1u; nx = cnt > 0u ? cnt : 1u;
}
__device__ __forceinline__ void xcd_barrier(const XcdBarrier& b) {
    asm volatile("s_waitcnt vmcnt(0)" ::: "memory");
    __syncthreads();
    if (threadIdx.x == 0) {
        unsigned* bar = b.bar;
        __builtin_amdgcn_s_waitcnt(0);
        unsigned nloc = b.st[0], nx = b.st[1];
        if (nloc == 0u) { xcd_barrier_complete(bar, b.x, nloc, nx); b.st[0] = nloc; b.st[1] = nx; }
        const unsigned old = xb_add(&bar[XB_XSUB(b.x)], 1u);
        const unsigned gen = old / nloc;
        if (old + 1u == (gen + 1u) * nloc) {
            __builtin_amdgcn_fence(__ATOMIC_RELEASE, "agent");
            asm volatile("s_waitcnt vmcnt(0)" ::: "memory");
            const unsigned og = xb_add(&bar[XB_TOP], 1u);
            const unsigned tg = og / nx;
            if (og + 1u == (tg + 1u) * nx) xb_add(&bar[XB_TOPGEN], 1u);
            else XB_SPIN(xb_ld(&bar[XB_TOPGEN]) == tg, bar);
            __builtin_amdgcn_fence(__ATOMIC_ACQUIRE, "agent");
            xb_add(&bar[XB_XGEN(b.x)], 1u);
            asm volatile("s_waitcnt vmcnt(0)" ::: "memory");
        } else {
            XB_SPIN(xb_ld(&bar[XB_XGEN(b.x)]) == gen, bar);
            __builtin_amdgcn_fence(__ATOMIC_ACQUIRE, "agent");
            asm volatile("s_waitcnt vmcnt(0)" ::: "memory");
        }
    }
    __syncthreads();
}

struct Args { const float* in[24]; float* out; unsigned char* ws; int ph_lo, ph_hi; };
enum { I_X = 0, I_ATTN_NORM, I_W_IN, I_CONV_W, I_CONV_B, I_A_LOG, I_DT_BIAS, I_D_SKIP, I_SSM_NORM, I_NA_RPB, I_MLA_QN, I_MLA_KVN, I_W_UQ, I_W_UKV, I_W_O, I_FFN_NORM,
       I_FFN_G, I_FFN_U, I_FFN_D, I_ROUTER, I_EXP_G, I_EXP_U, I_EXP_D, I_FINAL_NORM };

struct Ctx { LAS unsigned char* lds; int tid, lane, wave, G, bx, vcu; };


__device__ __forceinline__ int inproj_dest(int n) {
    if (n < 512) return C_Z + n;
    if (n < 1536) return C_XBC + (n - 512);
    if (n < 1552) return C_DT + (n - 1536);
    if (n < 2064) return C_NAQ + (n - 1552);
    if (n < 2576) return C_NAK + (n - 2064);
    if (n < 3088) return C_NAV + (n - 2576);
    if (n < 3600) return C_CQ + (n - 3088);
    if (n < 4112) return C_CKV + (n - 3600);
    if (n < 4144) return C_KR + (n - 4112);
    if (n < 4656) return C_DLQ + (n - 4144);
    if (n < 5168) return C_DLK + (n - 4656);
    return C_DLV + (n - 5168);
}
__device__ __forceinline__ int row_map(int mode, int n, int row_off) {
    if (mode == 1) return inproj_dest(n);
    if (mode == 2) return (n >> 7) * 256 + (n & 127);
    if (mode == 3) return (n >> 7) * 256 + 128 + (n & 127);
    return row_off + n;
}
__device__ __forceinline__ void tr_item(const float* W, int K, int N, bf16_t* WT, int mode, int row_off, LAS float* scr, int item, int lane, const float* gain = nullptr) {
    const int nblk = (N + 63) / 64, kb = item / nblk, nb = item - kb * nblk, k0 = 64 * kb, n0 = 64 * nb;
    const int kq = lane >> 4, n4 = (lane & 15) * 4; const bool nok = (n0 + n4) < N;
    f32x4 v[16];
    const float* src = W + (size_t)(k0 + kq) * N + n0 + n4;
#pragma unroll
    for (int i = 0; i < 16; ++i) v[i] = nok ? *(const f32x4*)(src + (size_t)(4 * i) * N) : (f32x4){0.f, 0.f, 0.f, 0.f};
#pragma unroll
    for (int i = 0; i < 16; ++i) { LAS float* d = scr + (4 * i + kq) * 65 + n4; d[0] = v[i].x; d[1] = v[i].y; d[2] = v[i].z; d[3] = v[i].w; }
    LDS_WAIT(); asm volatile("" ::: "memory");
    const int c = lane & 7;
    f32x4 g0 = (f32x4){1.f, 1.f, 1.f, 1.f}, g1 = g0; if (gain) { g0 = *(const f32x4*)(gain + k0 + 8 * c); g1 = *(const f32x4*)(gain + k0 + 8 * c + 4); }
#pragma unroll
    for (int j = 0; j < 8; ++j) { const int n = (lane >> 3) + 8 * j; const LAS float* s = scr + (8 * c) * 65 + n;
        if (n0 + n < N) {
            u32x4 o; o.x = cvt_pk_bf16(s[0 * 65] * g0.x, s[1 * 65] * g0.y); o.y = cvt_pk_bf16(s[2 * 65] * g0.z, s[3 * 65] * g0.w); o.z = cvt_pk_bf16(s[4 * 65] * g1.x, s[5 * 65] * g1.y); o.w = cvt_pk_bf16(s[6 * 65] * g1.z, s[7 * 65] * g1.w);
            *(u32x4*)(WT + (size_t)row_map(mode, n0 + n, row_off) * K + k0 + 8 * c) = o; } }
    LDS_WAIT(); asm volatile("" ::: "memory");
}
__device__ __forceinline__ void tr_item_f8(const float* W, int K, int N, unsigned char* WT, int mode, float scale, LAS float* scr, int item, int lane) {
    const int nblk = (N + 63) / 64, kb = item / nblk, nb = item - kb * nblk, k0 = 64 * kb, n0 = 64 * nb;
    const int kq = lane >> 4, n4 = (lane & 15) * 4; const bool nok = (n0 + n4) < N;
    f32x4 v[16];
    const float* src = W + (size_t)(k0 + kq) * N + n0 + n4;
#pragma unroll
    for (int i = 0; i < 16; ++i) v[i] = nok ? *(const f32x4*)(src + (size_t)(4 * i) * N) : (f32x4){0.f, 0.f, 0.f, 0.f};
#pragma unroll
    for (int i = 0; i < 16; ++i) { LAS float* d = scr + (4 * i + kq) * 65 + n4; d[0] = v[i].x; d[1] = v[i].y; d[2] = v[i].z; d[3] = v[i].w; }
    LDS_WAIT(); asm volatile("" ::: "memory");
    const int c = lane & 7;
#pragma unroll
    for (int j = 0; j < 8; ++j) { const int n = (lane >> 3) + 8 * j; const LAS float* s = scr + (8 * c) * 65 + n;
        if (n0 + n < N) {
            const unsigned w0 = pg8::pk_fp8x4(s[0 * 65] * scale, s[1 * 65] * scale, s[2 * 65] * scale, s[3 * 65] * scale), w1 = pg8::pk_fp8x4(s[4 * 65] * scale, s[5 * 65] * scale, s[6 * 65] * scale, s[7 * 65] * scale);
            *(u32x2*)(WT + (size_t)row_map(mode, n0 + n, 0) * K + k0 + 8 * c) = (u32x2){w0, w1}; } }
    LDS_WAIT(); asm volatile("" ::: "memory");
}
struct ConvJob { const float* W; unsigned char* WT; const float* gain; int K, N, mode, row_off, f8, item, kb, nb; };
constexpr int CI_O = 32 * 64, CI_G = 32 * 176, CI_IN = 32 * 178, CI_UQ = 8 * 24, CI_UKV = 8 * 32;
#ifndef CONV_EXP0
#define CONV_EXP0 4
#endif
constexpr int CONV_N0 = 2 * CI_O + 3 * CI_G + CI_IN + CI_UQ + CI_UKV + CONV_EXP0 * 3 * CI_G, CONV_N1 = (8 - CONV_EXP0) * 3 * CI_G;
#define CJ_KN(NN) { constexpr int nbk_ = ((NN) + 31) >> 5; j.kb = r / nbk_; j.nb = r - j.kb * nbk_; }
__device__ __forceinline__ bool conv_decode(const Args& a, int list, int it, ConvJob& j) {
    unsigned char* ws = a.ws; int r = it; j.f8 = 0; j.row_off = 0; j.mode = 0; j.gain = nullptr;
    if (list == 0) {
        if (r >= CONV_N0) return false;
        if (r < CI_O) { j.W = a.in[I_W_O]; j.WT = ws + WS_WO; j.K = D; j.N = D; j.item = r; CJ_KN(D) return true; } r -= CI_O;
#ifdef DENSE_F8
        constexpr int DF8 = 1, DF8D = 1;
#elif defined(DENSE_DOWN_F8)
        constexpr int DF8 = 0, DF8D = 1;
#else
        constexpr int DF8 = 0, DF8D = 0;
#endif
        if (r < CI_G) { j.W = a.in[I_FFN_G]; j.WT = ws + WS_WGU; j.K = D; j.N = FF; j.mode = 2; j.f8 = DF8; j.item = r; CJ_KN(FF) j.gain = NORM_FOLD ? a.in[I_FFN_NORM] : nullptr; return true; } r -= CI_G;
        if (r < CI_G) { j.W = a.in[I_FFN_U]; j.WT = ws + WS_WGU; j.K = D; j.N = FF; j.mode = 3; j.f8 = DF8; j.item = r; CJ_KN(FF) j.gain = NORM_FOLD ? a.in[I_FFN_NORM] : nullptr; return true; } r -= CI_G;
        if (r < CI_G) { j.W = a.in[I_FFN_D]; j.WT = ws + WS_WDN; j.K = FF; j.N = D; j.f8 = DF8D; j.item = r; CJ_KN(D) return true; } r -= CI_G;
        if (r < CI_IN) { j.W = a.in[I_W_IN] + (size_t)D * DIN; j.WT = ws + WS_WIN + SZ_WIN; j.K = D; j.N = DIN; j.mode = 1; j.item = r; CJ_KN(DIN) j.gain = NORM_FOLD ? a.in[I_ATTN_NORM] + D : nullptr; return true; } r -= CI_IN;
        if (r < CI_O) { j.W = a.in[I_W_O] + (size_t)D * D; j.WT = ws + WS_WO + SZ_WO; j.K = D; j.N = D; j.item = r; CJ_KN(D) return true; } r -= CI_O;
        if (r < CI_UQ) { j.W = a.in[I_W_UQ] + (size_t)512 * 768; j.WT = ws + WS_WUQKV + SZ_WUQKV; j.K = 512; j.N = 768; j.item = r; CJ_KN(768) j.gain = NORM_FOLD ? a.in[I_MLA_QN] + 512 : nullptr; return true; } r -= CI_UQ;
        if (r < CI_UKV) { j.W = a.in[I_W_UKV] + (size_t)512 * 1024; j.WT = ws + WS_WUQKV + SZ_WUQKV; j.K = 512; j.N = 1024; j.row_off = 768; j.item = r; CJ_KN(1024) j.gain = NORM_FOLD ? a.in[I_MLA_KVN] + 512 : nullptr; return true; } r -= CI_UKV;
    } else { if (r >= CONV_N1) return false; }
    const int e = (list ? CONV_EXP0 : 0) + r / (3 * CI_G); r -= (r / (3 * CI_G)) * (3 * CI_G); j.f8 = 1;
    if (r < CI_G) { j.W = a.in[I_EXP_G] + (size_t)e * D * FF; j.WT = ws + WS_WEGU + e * SZ_WGU8; j.K = D; j.N = FF; j.mode = 2; j.item = r; CJ_KN(FF) return true; } r -= CI_G;
    if (r < CI_G) { j.W = a.in[I_EXP_U] + (size_t)e * D * FF; j.WT = ws + WS_WEGU + e * SZ_WGU8; j.K = D; j.N = FF; j.mode = 3; j.item = r; CJ_KN(FF) return true; } r -= CI_G;
    j.W = a.in[I_EXP_D] + (size_t)e * FF * D; j.WT = ws + WS_WEDN + e * SZ_WDN8; j.K = FF; j.N = D; j.item = r; CJ_KN(D) return true;
}
#undef CJ_KN
__device__ __forceinline__ void conv_issue(const ConvJob& j, f32x4 (&v)[8], int lane) {
    const int k0 = 64 * j.kb, n0 = 32 * j.nb;
    const int n4 = (lane & 7) * 4; const bool nok = (n0 + n4) < j.N;
    const float* src = j.W + (size_t)(k0 + 8 * (lane >> 3)) * j.N + n0 + n4;
#pragma unroll
    for (int i = 0; i < 8; ++i) v[i] = nok ? __builtin_nontemporal_load((const f32x4*)(src + (size_t)i * j.N)) : (f32x4){0.f, 0.f, 0.f, 0.f};
}
__device__ __forceinline__ void conv_finish(const ConvJob& j, const f32x4 (&v)[8], LAS float*  , int lane) {
    const int k0 = 64 * j.kb + 8 * (lane >> 3), n0 = 32 * j.nb + (lane & 7) * 4;
    if (n0 < j.N) {
        f32x4 g0 = (f32x4){1.f, 1.f, 1.f, 1.f}, g1 = g0;
        if (j.gain) { g0 = *(const f32x4*)(j.gain + k0); g1 = *(const f32x4*)(j.gain + k0 + 4); }
#pragma unroll
        for (int c = 0; c < 4; ++c) { const size_t row = (size_t)row_map(j.mode, n0 + c, j.row_off);
            const float x0 = v[0][c] * g0.x, x1 = v[1][c] * g0.y, x2 = v[2][c] * g0.z, x3 = v[3][c] * g0.w, x4 = v[4][c] * g1.x, x5 = v[5][c] * g1.y, x6 = v[6][c] * g1.z, x7 = v[7][c] * g1.w;
            if (j.f8) { const unsigned w0 = pg8::pk_fp8x4(x0 * WSCALE8, x1 * WSCALE8, x2 * WSCALE8, x3 * WSCALE8), w1 = pg8::pk_fp8x4(x4 * WSCALE8, x5 * WSCALE8, x6 * WSCALE8, x7 * WSCALE8);
                *(u32x2*)(j.WT + row * j.K + k0) = (u32x2){w0, w1}; }
            else { u32x4 o; o.x = cvt_pk_bf16(x0, x1); o.y = cvt_pk_bf16(x2, x3); o.z = cvt_pk_bf16(x4, x5); o.w = cvt_pk_bf16(x6, x7);
                *(u32x4*)((bf16_t*)j.WT + row * j.K + k0) = o; } }
    }
}
__device__ __forceinline__ void p0_convert(const Ctx& F, const Args& a) {
    LAS float* scr = (LAS float*)(F.lds + F.wave * 16640);
    const int gw = F.vcu * 8 + F.wave, NGW = F.G * 8;
    unsigned char* ws = a.ws;
    constexpr int I_IN = 32 * 89, I_UQ = 8 * 12, I_UKV = 8 * 16;
    constexpr int NITEMS = I_IN + I_UQ + I_UKV;
    for (int it = gw; it < NITEMS; it += NGW) {
        int r = it;
        if (r < I_IN) { tr_item(a.in[I_W_IN], D, DIN, (bf16_t*)(ws + WS_WIN), 1, 0, scr, r, F.lane, NORM_FOLD ? a.in[I_ATTN_NORM] : nullptr); continue; } r -= I_IN;
        if (r < I_UQ) { tr_item(a.in[I_W_UQ], 512, 768, (bf16_t*)(ws + WS_WUQKV), 0, 0, scr, r, F.lane, NORM_FOLD ? a.in[I_MLA_QN] : nullptr); continue; } r -= I_UQ;
        tr_item(a.in[I_W_UKV], 512, 1024, (bf16_t*)(ws + WS_WUQKV), 0, 768, scr, r, F.lane, NORM_FOLD ? a.in[I_MLA_KVN] : nullptr);
    }
    { const int gt = F.vcu * 512 + F.tid, NGT = F.G * 512; constexpr int PADV = (DINP - DIN) * D * 2 / 16;
      for (int i = gt; i < 2 * PADV; i += NGT) { const int l = i / PADV, j = i - l * PADV; ((u32x4*)(ws + WS_WIN + l * SZ_WIN + (size_t)DIN * D * 2))[j] = (u32x4){0u, 0u, 0u, 0u}; } }
    { const int gt = F.vcu * 512 + F.tid, NGT = F.G * 512;
      for (int i = gt; i < T * 32; i += NGT) { const int t = i >> 5, f = i & 31; const float inv = exp2f(-(float)f * (13.287712379549449f / 32.0f)); const float ang = (float)t * inv;
          ((f32x2*)(ws + WS_ROPE))[i] = (f32x2){cosf(ang), sinf(ang)}; } }
}

__device__ __forceinline__ void rms_load(const float* xrow, const bf16_t* y0row, f32x4 (&v)[8], float& rstd, int lane) {
    float ss = 0.f;
#pragma unroll
    for (int j = 0; j < 8; ++j) { v[j] = ((const f32x4*)xrow)[lane + 64 * j]; if (y0row) { const u32x2 yy = ((const u32x2*)y0row)[lane + 64 * j]; v[j] += (f32x4){bf_lo(yy.x), bf_hi(yy.x), bf_lo(yy.y), bf_hi(yy.y)}; } ss += (v[j].x * v[j].x + v[j].y * v[j].y) + (v[j].z * v[j].z + v[j].w * v[j].w); }
    ss = wave_sum(ss);
    rstd = 1.0f / sqrtf(ss * (1.0f / D) + NORM_EPS);
}
__device__ __forceinline__ void rms_load(const bf16_t* xrow, const bf16_t* y0row, f32x4 (&v)[8], float& rstd, int lane) {
    float ss = 0.f;
#pragma unroll
    for (int j = 0; j < 8; ++j) { const u32x2 xx = ((const u32x2*)xrow)[lane + 64 * j]; v[j] = (f32x4){bf_lo(xx.x), bf_hi(xx.x), bf_lo(xx.y), bf_hi(xx.y)};
        if (y0row) { const unsigned y8 = ((const unsigned*)y0row)[lane + 64 * j];
            const auto ylo = __builtin_amdgcn_cvt_pk_f32_fp8((int)y8, false), yhi = __builtin_amdgcn_cvt_pk_f32_fp8((int)y8, true);
            v[j] += (f32x4){ylo[0], ylo[1], yhi[0], yhi[1]} * (1.0f / Y0SCALE); } ss += (v[j].x * v[j].x + v[j].y * v[j].y) + (v[j].z * v[j].z + v[j].w * v[j].w); }
    ss = wave_sum(ss);
    rstd = 1.0f / sqrtf(ss * (1.0f / D) + NORM_EPS);
}
template <class XT>
__device__ __forceinline__ void phase_rowstats(const Ctx& F, const XT* x, float* rstd_out) {
    const int gw = F.vcu * 8 + F.wave, NGW = F.G * 8;
    for (int m = gw; m < M; m += NGW) { f32x4 v[8]; float rstd; rms_load(x + (size_t)m * D, nullptr, v, rstd, F.lane); if (F.lane == 0) rstd_out[m] = rstd; }
}
__device__ __forceinline__ void phase_x_bf16_stats(const Ctx& F, const float* x, bf16_t* xb, float* rstd_out) {
    const int gw = F.vcu * 8 + F.wave, NGW = F.G * 8;
    for (int m = gw; m < M; m += NGW) { f32x4 v[8]; float rstd; rms_load(x + (size_t)m * D, nullptr, v, rstd, F.lane);
        u32x2* o = (u32x2*)(xb + (size_t)m * D);
#pragma unroll
        for (int j = 0; j < 8; ++j) o[F.lane + 64 * j] = (u32x2){cvt_pk_bf16(v[j].x, v[j].y), cvt_pk_bf16(v[j].z, v[j].w)};
        if (F.lane == 0) rstd_out[m] = rstd; }
}
template <class XT>
__device__ __forceinline__ void phase_rmsnorm_bf16(const Ctx& F, const XT* x, const float* w, bf16_t* out) {
    const int gw = F.vcu * 8 + F.wave, NGW = F.G * 8;
    for (int m = gw; m < M; m += NGW) {
        f32x4 v[8]; float rstd; rms_load(x + (size_t)m * D, nullptr, v, rstd, F.lane);
        u32x2* o = (u32x2*)(out + (size_t)m * D);
#pragma unroll
        for (int j = 0; j < 8; ++j) { const f32x4 wv = ((const f32x4*)w)[F.lane + 64 * j]; const f32x4 y = v[j] * rstd * wv; o[F.lane + 64 * j] = (u32x2){cvt_pk_bf16(y.x, y.y), cvt_pk_bf16(y.z, y.w)}; }
    }
}
template <class XT>
__device__ __forceinline__ void phase_rmsnorm_f8(const Ctx& F, const XT* x, const float* w, unsigned char* out) {
    const int gw = F.vcu * 8 + F.wave, NGW = F.G * 8;
    for (int m = gw; m < M; m += NGW) {
        f32x4 v[8]; float rstd; rms_load(x + (size_t)m * D, nullptr, v, rstd, F.lane);
        unsigned* o = (unsigned*)(out + (size_t)m * D);
#pragma unroll
        for (int j = 0; j < 8; ++j) { const f32x4 wv = ((const f32x4*)w)[F.lane + 64 * j]; const f32x4 y = v[j] * rstd * wv; o[F.lane + 64 * j] = pg8::pk_fp8x4(y.x, y.y, y.z, y.w); }
    }
}
template <class XT>
__device__ __forceinline__ void phase_final_norm(const Ctx& F, const XT* x, const bf16_t* y0, const float* w, float* out) {
    const int gw = F.vcu * 8 + F.wave, NGW = F.G * 8;
    for (int m = gw; m < M; m += NGW) {
        f32x4 v[8]; float rstd; rms_load(x + (size_t)m * D, (const bf16_t*)((const unsigned char*)y0 + (size_t)m * D), v, rstd, F.lane);
        f32x4* o = (f32x4*)(out + (size_t)m * D);
#pragma unroll
        for (int j = 0; j < 8; ++j) { const f32x4 wv = ((const f32x4*)w)[F.lane + 64 * j]; o[F.lane + 64 * j] = v[j] * rstd * wv; }
    }
}
template <class XT>
__device__ __forceinline__ void phase_rmsnorm_router(const Ctx& F, const XT* x, const float* w, const float* router  , bf16_t* out, unsigned char* ws) {
    LAS int* hist = (LAS int*)(F.lds);
    if (F.tid < 8) hist[F.tid] = 0;
    __syncthreads();
    const int rows_per_wg = M / F.G;
    for (int i = F.wave; i < rows_per_wg; i += 8) {
        const int m = F.bx * rows_per_wg + i;
        f32x4 v[8]; float rstd; rms_load(x + (size_t)m * D, nullptr, v, rstd, F.lane);
        unsigned* o = (unsigned*)((unsigned char*)out + (size_t)m * D);
        float lg[8];
#pragma unroll
        for (int e = 0; e < 8; ++e) lg[e] = 0.f;
#pragma unroll
        for (int j = 0; j < 8; ++j) { const f32x4 wv = ((const f32x4*)w)[F.lane + 64 * j]; const f32x4 y = v[j] * rstd * wv; o[F.lane + 64 * j] = pg8::pk_fp8x4(y.x, y.y, y.z, y.w);
            const float* rw = router + (size_t)(4 * (F.lane + 64 * j)) * 8;
#pragma unroll
            for (int q = 0; q < 4; ++q) { const f32x4 r0 = ((const f32x4*)(rw + q * 8))[0], r1 = ((const f32x4*)(rw + q * 8))[1]; const float yy = y[q];
                lg[0] += yy * r0.x; lg[1] += yy * r0.y; lg[2] += yy * r0.z; lg[3] += yy * r0.w; lg[4] += yy * r1.x; lg[5] += yy * r1.y; lg[6] += yy * r1.z; lg[7] += yy * r1.w; } }
#pragma unroll
        for (int e = 0; e < 8; ++e) lg[e] = wave_sum(lg[e]);
        int e0 = 0; float v0 = lg[0];
#pragma unroll
        for (int e = 1; e < 8; ++e) if (lg[e] > v0) { v0 = lg[e]; e0 = e; }
        int e1 = -1; float v1 = -3.0e38f;
#pragma unroll
        for (int e = 0; e < 8; ++e) if (e != e0 && lg[e] > v1) { v1 = lg[e]; e1 = e; }
        const float g0 = 1.0f / (1.0f + __expf(v1 - v0)), g1 = 1.0f - g0;
        if (F.lane == 0) { ((u32x4*)(ws + WS_ROUTE))[m] = (u32x4){(unsigned)e0, (unsigned)e1, __float_as_uint(g0), __float_as_uint(g1)}; atomicAdd((int*)hist + e0, 1); atomicAdd((int*)hist + e1, 1); }
    }
    if (F.bx == 0) ((unsigned*)((unsigned char*)out + (size_t)M * D))[F.tid] = 0u;
    __syncthreads();
    if (F.tid < 8) ((int*)(ws + WS_HISTO))[F.bx * 8 + F.tid] = hist[F.tid];
    __syncthreads();
}

__device__ __forceinline__ void phase_token_local(const Ctx& F, const Args& a, int l, const bool dummy = false) {
    unsigned char* ws = a.ws;
    bf16_t* proj = (bf16_t*)(ws + AR_PROJ); bf16_t* xbc = (bf16_t*)(ws + AR_XBC); float* dtb = (float*)(ws + AR_DT);
    const float* cw = a.in[I_CONV_W] + (size_t)l * 5 * 1024; const float* cb = a.in[I_CONV_B] + (size_t)l * 1024;
    const float* dt_bias = a.in[I_DT_BIAS] + l * 16;
    const float* qnw = a.in[I_MLA_QN] + l * 512; const float* kvnw = a.in[I_MLA_KVN] + l * 512;
    const f32x2* rope = (const f32x2*)(ws + WS_ROPE);
    const int gw = F.vcu * 8 + F.wave, NGW = F.G * 8, lane = F.lane;
    float cwr[5][16], cbr[16];
#pragma unroll
    for (int j = 0; j < 4; ++j) { const f32x4 b4 = ((const f32x4*)cb)[4 * lane + j]; cbr[4 * j] = b4.x; cbr[4 * j + 1] = b4.y; cbr[4 * j + 2] = b4.z; cbr[4 * j + 3] = b4.w; }
#pragma unroll
    for (int k = 0; k < 5; ++k)
#pragma unroll
        for (int j = 0; j < 4; ++j) { const f32x4 w4 = ((const f32x4*)(cw + k * 1024 + 16 * lane))[j]; cwr[k][4 * j] = w4.x; cwr[k][4 * j + 1] = w4.y; cwr[k][4 * j + 2] = w4.z; cwr[k][4 * j + 3] = w4.w; }
    for (int mc = gw * 8; mc < M; mc += NGW * 8) {
    u32x4 win[5][2];
#pragma unroll
    for (int k = 0; k < 4; ++k) { const int tt = (mc & (T - 1)) + k - 2; const bool ok = tt >= 0 && tt < T; const u32x4* src = (const u32x4*)(proj + (size_t)(mc + k - 2) * DINP + C_XBC + 16 * lane);
        win[k + 1][0] = ok ? src[0] : (u32x4){0u, 0u, 0u, 0u}; win[k + 1][1] = ok ? src[1] : (u32x4){0u, 0u, 0u, 0u}; }
#pragma unroll 1
    for (int mi = 0; mi < 8; ++mi) {
        const int m = mc + mi;
        const int t = m & (T - 1);
        bf16_t* prow = proj + (size_t)m * DINP;
        bf16_t* wrow = dummy ? (bf16_t*)(ws + AR_ST) + (size_t)m * 3072 - C_CQ : prow;
        {
#pragma unroll
            for (int k = 0; k < 4; ++k) { win[k][0] = win[k + 1][0]; win[k][1] = win[k + 1][1]; }
            { const int tt = t + 2; const bool ok = tt < T; const u32x4* src = (const u32x4*)(prow + (ptrdiff_t)2 * DINP + C_XBC + 16 * lane);
              win[4][0] = ok ? src[0] : (u32x4){0u, 0u, 0u, 0u}; win[4][1] = ok ? src[1] : (u32x4){0u, 0u, 0u, 0u}; }
            float acc[16];
#pragma unroll
            for (int j = 0; j < 16; ++j) acc[j] = cbr[j];
#pragma unroll
            for (int k = 0; k < 5; ++k) { const unsigned xs[8] = {win[k][0].x, win[k][0].y, win[k][0].z, win[k][0].w, win[k][1].x, win[k][1].y, win[k][1].z, win[k][1].w};
#pragma unroll
                for (int j = 0; j < 8; ++j) { acc[2 * j] += cwr[k][2 * j] * bf_lo(xs[j]); acc[2 * j + 1] += cwr[k][2 * j + 1] * bf_hi(xs[j]); } }
            u32x4 o0, o1;
            o0.x = cvt_pk_bf16(silu_f(acc[0]), silu_f(acc[1])); o0.y = cvt_pk_bf16(silu_f(acc[2]), silu_f(acc[3])); o0.z = cvt_pk_bf16(silu_f(acc[4]), silu_f(acc[5])); o0.w = cvt_pk_bf16(silu_f(acc[6]), silu_f(acc[7]));
            o1.x = cvt_pk_bf16(silu_f(acc[8]), silu_f(acc[9])); o1.y = cvt_pk_bf16(silu_f(acc[10]), silu_f(acc[11])); o1.z = cvt_pk_bf16(silu_f(acc[12]), silu_f(acc[13])); o1.w = cvt_pk_bf16(silu_f(acc[14]), silu_f(acc[15]));
            u32x4* dst = (u32x4*)(xbc + (size_t)m * 1024 + 16 * lane); dst[0] = o0; dst[1] = o1;
        }
        if (lane < 16) { const float v = bf2f(prow[C_DT + lane]) + dt_bias[lane]; dtb[(size_t)m * 16 + lane] = v > 20.f ? v : log1pf(__expf(v)); }
        {
            const int hh = lane >> 2, qq = lane & 3;
            u32x4* p1 = (u32x4*)(prow + C_DLQ + hh * 64 + 8 * qq); u32x4* p2 = (u32x4*)(prow + C_DLQ + hh * 64 + 32 + 8 * qq);
            const u32x4 a1 = *p1, a2 = *p2;
            const f32x4* cs4 = (const f32x4*)(rope + (size_t)t * 32 + 8 * qq);
            const unsigned x1[4] = {a1.x, a1.y, a1.z, a1.w}, x2[4] = {a2.x, a2.y, a2.z, a2.w}; unsigned o1[4], o2[4];
#pragma unroll
            for (int j = 0; j < 4; ++j) { const f32x4 c = cs4[j];
                const float u0 = bf_lo(x1[j]), u1 = bf_hi(x1[j]), w0 = bf_lo(x2[j]), w1 = bf_hi(x2[j]);
                o1[j] = cvt_pk_bf16(u0 * c.x - w0 * c.y, u1 * c.z - w1 * c.w); o2[j] = cvt_pk_bf16(w0 * c.x + u0 * c.y, w1 * c.z + u1 * c.w); }
            *(u32x4*)(wrow + ((bf16_t*)p1 - prow)) = (u32x4){o1[0], o1[1], o1[2], o1[3]}; *(u32x4*)(wrow + ((bf16_t*)p2 - prow)) = (u32x4){o2[0], o2[1], o2[2], o2[3]};
        }
        if (lane < 2) {
            u32x4* p1 = (u32x4*)(prow + C_KR + 8 * lane); u32x4* p2 = (u32x4*)(prow + C_KR + 16 + 8 * lane);
            const u32x4 a1 = *p1, a2 = *p2; const unsigned x1[4] = {a1.x, a1.y, a1.z, a1.w}, x2[4] = {a2.x, a2.y, a2.z, a2.w}; unsigned o1[4], o2[4];
#pragma unroll
            for (int j = 0; j < 4; ++j) { const f32x2 c0 = rope[(size_t)t * 32 + 2 * (8 * lane + 2 * j)], c1 = rope[(size_t)t * 32 + 2 * (8 * lane + 2 * j + 1)];
                const float u0 = bf_lo(x1[j]), u1 = bf_hi(x1[j]), w0 = bf_lo(x2[j]), w1 = bf_hi(x2[j]);
                o1[j] = cvt_pk_bf16(u0 * c0.x - w0 * c0.y, u1 * c1.x - w1 * c1.y); o2[j] = cvt_pk_bf16(w0 * c0.x + u0 * c0.y, w1 * c1.x + u1 * c1.y); }
            *(u32x4*)(wrow + ((bf16_t*)p1 - prow)) = (u32x4){o1[0], o1[1], o1[2], o1[3]}; *(u32x4*)(wrow + ((bf16_t*)p2 - prow)) = (u32x4){o2[0], o2[1], o2[2], o2[3]};
        }
#pragma unroll
        for (int which = 0; which < 2; ++which) {
            u32x4* p = (u32x4*)(prow + (which ? C_CKV : C_CQ) + 8 * lane); const float* nw = (which ? kvnw : qnw) + 8 * lane;
            const u32x4 av = *p; const unsigned xs[4] = {av.x, av.y, av.z, av.w}; float f[8]; float ss = 0.f;
#pragma unroll
            for (int j = 0; j < 4; ++j) { f[2 * j] = bf_lo(xs[j]); f[2 * j + 1] = bf_hi(xs[j]); ss += f[2 * j] * f[2 * j] + f[2 * j + 1] * f[2 * j + 1]; }
            ss = wave_sum(ss); const float rstd = 1.0f / sqrtf(ss * (1.0f / 512.0f) + NORM_EPS);
#if NORM_FOLD
            if (lane == 0 && !dummy) ((float*)(ws + WS_RSTD2))[(size_t)m * 2 + which] = rstd;
            (void)nw;
#else
            const f32x4 w0 = ((const f32x4*)nw)[0], w1 = ((const f32x4*)nw)[1];
            *(u32x4*)(wrow + ((bf16_t*)p - prow)) = (u32x4){cvt_pk_bf16(f[0] * rstd * w0.x, f[1] * rstd * w0.y), cvt_pk_bf16(f[2] * rstd * w0.z, f[3] * rstd * w0.w), cvt_pk_bf16(f[4] * rstd * w1.x, f[5] * rstd * w1.y), cvt_pk_bf16(f[6] * rstd * w1.z, f[7] * rstd * w1.w)};
#endif
        }
    }
    }
}

__device__ __forceinline__ float wave_incl_scan(float v, int lane) {
#pragma unroll
    for (int o = 1; o < 64; o <<= 1) { const float t = __int_as_float(__builtin_amdgcn_ds_bpermute(((lane - o) & 63) << 2, __float_as_int(v))); if (lane >= o) v += t; }
    return v;
}
__device__ __forceinline__ bf16x8 scale8(bf16x8 a, const float* w) {
    u32x4 o;
    o.x = cvt_pk_bf16(bf2f((bf16_t)a[0]) * w[0], bf2f((bf16_t)a[1]) * w[1]); o.y = cvt_pk_bf16(bf2f((bf16_t)a[2]) * w[2], bf2f((bf16_t)a[3]) * w[3]);
    o.z = cvt_pk_bf16(bf2f((bf16_t)a[4]) * w[4], bf2f((bf16_t)a[5]) * w[5]); o.w = cvt_pk_bf16(bf2f((bf16_t)a[6]) * w[6], bf2f((bf16_t)a[7]) * w[7]);
    return __builtin_bit_cast(bf16x8, o);
}
__device__ __forceinline__ void phase_ssm_states(const Ctx& F, const Args& a, int l) {
    unsigned char* ws = a.ws;
    const bf16_t* xbc = (const bf16_t*)(ws + AR_XBC); const float* dtb = (const float*)(ws + AR_DT);
    float* csg = (float*)(ws + AR_CS); float* cdec = (float*)(ws + WS_CDEC); bf16_t* states = (bf16_t*)(ws + AR_ST);
    constexpr int XS_STRIDE = 144, XS_HEAD = 128 * XS_STRIDE, BS_OFF = 4 * XS_HEAD, BS_STRIDE = 272, WT_OFF = BS_OFF + 128 * BS_STRIDE;
    LAS unsigned char* lds = F.lds; LAS float* WT = (LAS float*)(lds + WT_OFF);
    const int lane = F.lane, wave = F.wave, tid = F.tid, hi = lane >> 5, g1 = (lane >> 4) & 1, q4 = (lane & 15) >> 2, p4 = lane & 3;
    for (int u = F.bx; u < NB * 32 * 2; u += F.G) {
        const int b = u >> 6, c = (u >> 1) & 31, g = u & 1; const size_t row0 = (size_t)b * T + c * 128;
#pragma unroll
        for (int i = 0; i < 8; ++i) { const int idx = tid + 512 * i, s = idx >> 5, ch = idx & 31;
            const u32x4 v = *(const u32x4*)(xbc + (row0 + s) * 1024 + 256 * g + 8 * ch); *(LAS u32x4*)(lds + (ch >> 3) * XS_HEAD + s * XS_STRIDE + (ch & 7) * 16) = v; }
#pragma unroll
        for (int i = 0; i < 4; ++i) { const int idx = tid + 512 * i, s = idx >> 4, ch = idx & 15;
            const u32x4 v = *(const u32x4*)(xbc + (row0 + s) * 1024 + 512 + 128 * g + 8 * ch); *(LAS u32x4*)(lds + BS_OFF + s * BS_STRIDE + ch * 16) = v; }
        const int hl = wave & 3, dir = wave >> 2, h = 4 * g + hl;
        {
            const float dt0 = dtb[(row0 + lane) * 16 + dir * 8 + h], dt1 = dtb[(row0 + 64 + lane) * 16 + dir * 8 + h];
            const float A = -__expf(a.in[I_A_LOG][l * 16 + dir * 8 + h]);
            const float da0 = dt0 * A, da1 = dt1 * A;
            float s0 = wave_incl_scan(da0, lane); const float tot0 = __int_as_float(__builtin_amdgcn_readlane(__float_as_int(s0), 63));
            float s1 = wave_incl_scan(da1, lane) + tot0; const float total = __int_as_float(__builtin_amdgcn_readlane(__float_as_int(s1), 63));
            float c0, c1, w0, w1;
            if (dir == 0) { c0 = s0; c1 = s1; w0 = __expf(total - s0) * dt0; w1 = __expf(total - s1) * dt1; }
            else { c0 = total - s0 + da0; c1 = total - s1 + da1; w0 = __expf(total - c0) * dt0; w1 = __expf(total - c1) * dt1; }
            float* cso = csg + ((size_t)(b * 2 + dir) * 8 + h) * T + c * 128;
            cso[lane] = c0; cso[64 + lane] = c1;
            if (lane == 0) cdec[((b * 2 + dir) * 8 + h) * 32 + c] = __expf(total);
            WT[wave * 128 + lane] = w0; WT[wave * 128 + 64 + lane] = w1;
        }
        __syncthreads();
        f32x16 acc[2][4];
#pragma unroll
        for (int pb = 0; pb < 2; ++pb)
#pragma unroll
            for (int nb = 0; nb < 4; ++nb) acc[pb][nb] = f32x16{};
        LAS const char* xs_base = (LAS const char*)lds + hl * XS_HEAD + (8 * hi + q4) * XS_STRIDE + (16 * g1 + 4 * p4) * 2;
        LAS const char* bs_base = (LAS const char*)lds + BS_OFF + (8 * hi + q4) * BS_STRIDE + (16 * g1 + 4 * p4) * 2;
#pragma unroll 1
        for (int ks = 0; ks < 8; ++ks) {
            float wl[8];
            { const f32x4 wa = *(LAS const f32x4*)(WT + wave * 128 + 16 * ks + 8 * hi), wb = *(LAS const f32x4*)(WT + wave * 128 + 16 * ks + 8 * hi + 4);
              wl[0] = wa.x; wl[1] = wa.y; wl[2] = wa.z; wl[3] = wa.w; wl[4] = wb.x; wl[5] = wb.y; wl[6] = wb.z; wl[7] = wb.w; }
            bf16x8 af[2], bfr[4];
#pragma unroll
            for (int pb = 0; pb < 2; ++pb) { const s16x4 lo = trr(xs_base + ks * 16 * XS_STRIDE + pb * 64), hh = trr(xs_base + ks * 16 * XS_STRIDE + 4 * XS_STRIDE + pb * 64); af[pb] = scale8(cat8(lo, hh), wl); }
#pragma unroll
            for (int nb = 0; nb < 4; ++nb) { const s16x4 lo = trr(bs_base + ks * 16 * BS_STRIDE + nb * 64), hh = trr(bs_base + ks * 16 * BS_STRIDE + 4 * BS_STRIDE + nb * 64); bfr[nb] = cat8(lo, hh); }
#pragma unroll
            for (int pb = 0; pb < 2; ++pb)
#pragma unroll
                for (int nb = 0; nb < 4; ++nb) acc[pb][nb] = __builtin_amdgcn_mfma_f32_32x32x16_bf16(af[pb], bfr[nb], acc[pb][nb], 0, 0, 0);
        }
        bf16_t* so = states + ((size_t)((b * 2 + dir) * 8 + h) * 32 + c) * 8192;
        const bool oddl = (lane & 1) != 0;
#pragma unroll
        for (int pb = 0; pb < 2; ++pb)
#pragma unroll
            for (int nb = 0; nb < 4; ++nb)
#pragma unroll
                for (int r = 0; r < 16; r += 2) { const float mine0 = acc[pb][nb][r], mine1 = acc[pb][nb][r + 1];
                    const float got = swz_xor<1>(oddl ? mine0 : mine1);
                    const unsigned w = oddl ? cvt_pk_bf16(got, mine1) : cvt_pk_bf16(mine0, got);
                    *(unsigned*)(so + (32 * pb + crow(r + (oddl ? 1 : 0), hi)) * 128 + 32 * nb + (lane & 31) - (oddl ? 1 : 0)) = w; }
        __syncthreads();
    }
}
__device__ __forceinline__ void phase_ssm_scan(const Ctx& F, const Args& a) {
    unsigned char* ws = a.ws;
    const bf16_t* states = (const bf16_t*)(ws + AR_ST); const float* cdec = (const float*)(ws + WS_CDEC); bf16_t* prev = (bf16_t*)(ws + AR_PREV);
    const int gt = F.vcu * 512 + F.tid, NGT = F.G * 512;
    for (int e4 = gt; e4 < NB * 2 * 8 * 2048; e4 += NGT) {
        const int bdh = e4 >> 11, off = (e4 & 2047) * 4, dir = (bdh >> 3) & 1;
        f32x4 carry = (f32x4){0.f, 0.f, 0.f, 0.f};
#pragma unroll 4
        for (int i = 0; i < 32; ++i) {
            const int c = dir ? 31 - i : i; const size_t o = ((size_t)bdh * 32 + c) * 8192 + off;
            const u32x2 sw = *(const u32x2*)(states + o); const f32x4 S = (f32x4){bf_lo(sw.x), bf_hi(sw.x), bf_lo(sw.y), bf_hi(sw.y)}; const float dec = cdec[bdh * 32 + c];
            *(u32x2*)(prev + o) = (u32x2){cvt_pk_bf16(carry.x, carry.y), cvt_pk_bf16(carry.z, carry.w)};
            carry = carry * dec + S;
        }
    }
}
__device__ __forceinline__ void phase_ssm_out(const Ctx& F, const Args& a, int l) {
    unsigned char* ws = a.ws;
    const bf16_t* xbc = (const bf16_t*)(ws + AR_XBC); const float* dtb = (const float*)(ws + AR_DT); const float* csg = (const float*)(ws + AR_CS);
    const bf16_t* prev = (const bf16_t*)(ws + AR_PREV); const bf16_t* proj = (const bf16_t*)(ws + AR_PROJ); bf16_t* mixed = (bf16_t*)(ws + AR_MIXED);
    constexpr int XS_STRIDE = 144, XS_HEAD = 128 * XS_STRIDE, BS_OFF = 4 * XS_HEAD, BC_STRIDE = 272, CS_OFF = BS_OFF + 128 * BC_STRIDE, TAB_OFF = CS_OFF + 64 * BC_STRIDE, SS_OFF = TAB_OFF + 4 * 2048;
    static_assert(SS_OFF + 2048 <= LDS_MISC, "ssm_out LDS");
    LAS unsigned char* lds = F.lds;
    const int lane = F.lane, tid = F.tid, hl = F.wave & 3, lb = F.wave >> 2, hi = lane >> 5, r32 = lane & 31, g1 = (lane >> 4) & 1, q4 = (lane & 15) >> 2, p4 = lane & 3;
    LAS float* tab = (LAS float*)(lds + TAB_OFF + hl * 2048);
    LAS float* SS = (LAS float*)(lds + SS_OFF);
    for (int u = F.bx; u < NB * 32 * 2; u += F.G) {
        const int b = u >> 6, c = (u >> 1) & 31, hf = u & 1; const size_t row0 = (size_t)b * T + c * 128;
        const int lloc = 64 * hf + 32 * lb + r32;
        unsigned ygp[2][2][8];
#pragma unroll
        for (int g = 0; g < 2; ++g) {
            const int h = 4 * g + hl;
#pragma unroll
            for (int i = 0; i < 8; ++i) { const int idx = tid + 512 * i, s = idx >> 5, ch = idx & 31;
                const u32x4 v = *(const u32x4*)(xbc + (row0 + s) * 1024 + 256 * g + 8 * ch); *(LAS u32x4*)(lds + (ch >> 3) * XS_HEAD + s * XS_STRIDE + (ch & 7) * 16) = v; }
#pragma unroll
            for (int i = 0; i < 4; ++i) { const int idx = tid + 512 * i, s = idx >> 4, ch = idx & 15;
                const u32x4 v = *(const u32x4*)(xbc + (row0 + s) * 1024 + 512 + 128 * g + 8 * ch); *(LAS u32x4*)(lds + BS_OFF + s * BC_STRIDE + ch * 16) = v; }
#pragma unroll
            for (int i = 0; i < 2; ++i) { const int idx = tid + 512 * i, s = idx >> 4, ch = idx & 15;
                const u32x4 v = *(const u32x4*)(xbc + (row0 + 64 * hf + s) * 1024 + 768 + 128 * g + 8 * ch); *(LAS u32x4*)(lds + CS_OFF + s * BC_STRIDE + ch * 16) = v; }
            { const int th = tid >> 7, s = tid & 127, hh_ = 4 * g + th; LAS float* tb = (LAS float*)(lds + TAB_OFF + th * 2048);
              tb[s] = csg[((size_t)(b * 2 + 0) * 8 + hh_) * T + c * 128 + s]; tb[128 + s] = csg[((size_t)(b * 2 + 1) * 8 + hh_) * T + c * 128 + s];
              tb[256 + s] = dtb[(row0 + s) * 16 + hh_]; tb[384 + s] = dtb[(row0 + s) * 16 + 8 + hh_]; }
            __syncthreads();
            const float dskip = a.in[I_D_SKIP][l * 8 + h];
            const float csf_l = tab[lloc], csb_l = tab[128 + lloc];
            LAS const char* cf_base = (LAS const char*)lds + CS_OFF + (32 * lb + r32) * BC_STRIDE + 16 * hi;
#define CF(ks) (*(LAS const bf16x8*)(cf_base + 32 * (ks)))
            f32x16 y[2]; y[0] = f32x16{}; y[1] = f32x16{};
            LAS const char* xs_base = (LAS const char*)lds + hl * XS_HEAD + (4 * hi + q4) * XS_STRIDE + (16 * g1 + 4 * p4) * 2;
#pragma unroll 1
            for (int sb = 0; sb < 4; ++sb) {
                f32x16 gt = f32x16{};
                {
                    bf16x8 Bf[8];
#pragma unroll
                    for (int ks = 0; ks < 8; ++ks) Bf[ks] = *(LAS const bf16x8*)(lds + BS_OFF + (32 * sb + r32) * BC_STRIDE + (16 * ks + 8 * hi) * 2);
#pragma unroll
                    for (int kh = 0; kh < 4; ++kh) { const bf16x8 c0 = CF(2 * kh), c1 = CF(2 * kh + 1);
                        __builtin_amdgcn_sched_barrier(0);
                        gt = __builtin_amdgcn_mfma_f32_32x32x16_bf16(Bf[2 * kh], c0, gt, 0, 0, 0); gt = __builtin_amdgcn_mfma_f32_32x32x16_bf16(Bf[2 * kh + 1], c1, gt, 0, 0, 0); }
                }

                unsigned pw[8];
#pragma unroll
                for (int r2 = 0; r2 < 8; ++r2) { float pv2[2];
#pragma unroll
                    for (int e = 0; e < 2; ++e) { const int r = 2 * r2 + e; const int s = 32 * sb + crow(r, hi);
                        const float ef = __expf(fminf(csf_l - tab[s], 0.f)) * tab[256 + s], eb = __expf(fminf(csb_l - tab[128 + s], 0.f)) * tab[384 + s];
                        const float wsum = (s <= lloc ? ef : 0.f) + (s >= lloc ? eb : 0.f);
                        pv2[e] = gt[r] * wsum + (s == lloc ? dskip : 0.f); }
                    pw[r2] = cvt_pk_bf16(pv2[0], pv2[1]); }
                u32x4 w0, w1;
                w0.x = pw[0]; w0.y = pw[1]; w0.z = pw[2]; w0.w = pw[3]; w1.x = pw[4]; w1.y = pw[5]; w1.z = pw[6]; w1.w = pw[7];
                const bf16x8 pb0 = __builtin_bit_cast(bf16x8, w0), pb1 = __builtin_bit_cast(bf16x8, w1);
#pragma unroll
                for (int pb = 0; pb < 2; ++pb)
#pragma unroll
                    for (int s2 = 0; s2 < 2; ++s2) { LAS const char* p = xs_base + (32 * sb + 16 * s2) * XS_STRIDE + pb * 64;
                        const s16x4 lo = trr(p), hh = trr(p + 8 * XS_STRIDE);
                        y[pb] = __builtin_amdgcn_mfma_f32_32x32x16_bf16(cat8(lo, hh), s2 ? pb1 : pb0, y[pb], 0, 0, 0); }
            }
#pragma unroll
            for (int dir = 0; dir < 2; ++dir) {
                const float el = __expf(dir ? csb_l : csf_l);
                const bf16_t* pv = prev + ((size_t)((b * 2 + dir) * 8 + h) * 32 + c) * 8192;
#pragma unroll
                for (int pb = 0; pb < 2; ++pb) { f32x16 ta = f32x16{};
                    bf16x8 Pf[8];
#pragma unroll
                    for (int ks = 0; ks < 8; ++ks) Pf[ks] = *(const bf16x8*)(pv + (32 * pb + r32) * 128 + 16 * ks + 8 * hi);
                    __builtin_amdgcn_sched_barrier(0);
#pragma unroll
                    for (int ks = 0; ks < 8; ++ks) ta = __builtin_amdgcn_mfma_f32_32x32x16_bf16(Pf[ks], CF(ks), ta, 0, 0, 0);
#pragma unroll
                    for (int r = 0; r < 16; ++r) y[pb][r] += el * ta[r];
                    __builtin_amdgcn_sched_barrier(0); }
            }
            float sq = 0.f;
            const bf16_t* zrow = proj + (row0 + lloc) * DINP + C_Z + h * 64;
#pragma unroll
            for (int pb = 0; pb < 2; ++pb)
#pragma unroll
                for (int g4 = 0; g4 < 4; ++g4) { const u32x2 zz = *(const u32x2*)(zrow + 32 * pb + 8 * g4 + 4 * hi);
                    const float z0 = bf_lo(zz.x), z1 = bf_hi(zz.x), z2 = bf_lo(zz.y), z3 = bf_hi(zz.y);
                    float v0 = y[pb][4 * g4] * silu_f(z0), v1 = y[pb][4 * g4 + 1] * silu_f(z1), v2 = y[pb][4 * g4 + 2] * silu_f(z2), v3 = y[pb][4 * g4 + 3] * silu_f(z3);
                    ygp[g][pb][2 * g4] = cvt_pk_bf16(v0, v1); ygp[g][pb][2 * g4 + 1] = cvt_pk_bf16(v2, v3);
                    sq += (v0 * v0 + v1 * v1) + (v2 * v2 + v3 * v3); }
            sq = xhalf_sum(sq);
#undef CF
            if (hi == 0) SS[h * 64 + 32 * lb + r32] = sq;
            __syncthreads();
        }
        float tot = 0.f;
#pragma unroll
        for (int w = 0; w < 8; ++w) tot += SS[w * 64 + 32 * lb + r32];
        const float rstd = 1.0f / sqrtf(tot * (1.0f / 512.0f) + NORM_EPS);
#pragma unroll
        for (int g = 0; g < 2; ++g) {
            const int h = 4 * g + hl; const float* nw = a.in[I_SSM_NORM] + l * 512 + h * 64;
            bf16_t* orow = mixed + (row0 + lloc) * D + h * 64;
            f32x4 wv[2][4];
#pragma unroll
            for (int pb = 0; pb < 2; ++pb)
#pragma unroll
                for (int g4 = 0; g4 < 4; ++g4) wv[pb][g4] = *(const f32x4*)(nw + 32 * pb + 8 * g4 + 4 * hi);
            asm volatile("" ::: "memory");
#pragma unroll
            for (int pb = 0; pb < 2; ++pb)
#pragma unroll
                for (int g4 = 0; g4 < 4; ++g4) { const int p0 = 32 * pb + 8 * g4 + 4 * hi; const f32x4 w4 = wv[pb][g4];
                    const float v0 = bf_lo(ygp[g][pb][2 * g4]), v1 = bf_hi(ygp[g][pb][2 * g4]), v2 = bf_lo(ygp[g][pb][2 * g4 + 1]), v3 = bf_hi(ygp[g][pb][2 * g4 + 1]);
                    *(u32x2*)(orow + p0) = (u32x2){cvt_pk_bf16(v0 * rstd * w4.x, v1 * rstd * w4.y), cvt_pk_bf16(v2 * rstd * w4.z, v3 * rstd * w4.w)}; }
        }
        __syncthreads();
    }
}
__device__ __forceinline__ void phase_dil_merge(const Ctx& F, const Args& a) {
    unsigned char* ws = a.ws;
    const bf16_t* dilp = (const bf16_t*)(ws + AR_DILP); const float* dlse = (const float*)(ws + AR_DLSE); bf16_t* mixed = (bf16_t*)(ws + AR_MIXED);
    const int gw = F.vcu * 8 + F.wave, NGW = F.G * 8, lane = F.lane, hd = lane >> 3;
    for (int m = gw; m < M; m += NGW) {
        float ls[3]; u32x2 ov[3];
#pragma unroll
        for (int br = 0; br < 3; ++br) { ls[br] = dlse[((size_t)br * M + m) * 8 + hd]; ov[br] = *(const u32x2*)((const unsigned char*)dilp + ((size_t)br * M + m) * 512 + 8 * lane); }
        const float mx = fmaxf(ls[0], fmaxf(ls[1], ls[2]));
        float w[3]; float wsum = 0.f;
#pragma unroll
        for (int br = 0; br < 3; ++br) { w[br] = __expf(ls[br] - mx); wsum += w[br]; }
        const float inv = 1.0f / wsum; float o[8];
#pragma unroll
        for (int j = 0; j < 8; ++j) o[j] = 0.f;
#pragma unroll
        for (int br = 0; br < 3; ++br) { const float wb = w[br] * inv * (1.0f / 16.0f);
            const auto a0 = __builtin_amdgcn_cvt_pk_f32_fp8((int)ov[br].x, false), a1 = __builtin_amdgcn_cvt_pk_f32_fp8((int)ov[br].x, true), a2 = __builtin_amdgcn_cvt_pk_f32_fp8((int)ov[br].y, false), a3 = __builtin_amdgcn_cvt_pk_f32_fp8((int)ov[br].y, true);
            o[0] += wb * a0[0]; o[1] += wb * a0[1]; o[2] += wb * a1[0]; o[3] += wb * a1[1]; o[4] += wb * a2[0]; o[5] += wb * a2[1]; o[6] += wb * a3[0]; o[7] += wb * a3[1]; }
        *(u32x4*)(mixed + (size_t)m * D + 1536 + 8 * lane) = (u32x4){cvt_pk_bf16(o[0], o[1]), cvt_pk_bf16(o[2], o[3]), cvt_pk_bf16(o[4], o[5]), cvt_pk_bf16(o[6], o[7])};
    }
}

struct AttnAcc { f32x16 o[2]; float m, l; };
__device__ __forceinline__ void attn_init(AttnAcc& s) { s.o[0] = f32x16{}; s.o[1] = f32x16{}; s.m = -__builtin_inff(); s.l = 0.f; }
template <int DHS>
__device__ __forceinline__ void attn_block(AttnAcc& st, f32x16& sc, LAS const char* vb, int lane) {
    const int hi = lane >> 5, g1 = (lane >> 4) & 1, q4 = (lane & 15) >> 2, p4 = lane & 3;
    float mx = sc[0];
#pragma unroll
    for (int r = 1; r < 16; ++r) mx = fmaxf(mx, sc[r]);
    mx = xhalf_max(mx);
    const float mn = fmaxf(st.m, mx);
    const float mu = (mn == -__builtin_inff()) ? 0.f : mn;
    const float alpha = __builtin_amdgcn_exp2f(st.m - mu);
    float sum = 0.f;
#pragma unroll
    for (int r = 0; r < 16; ++r) { sc[r] = __builtin_amdgcn_exp2f(sc[r] - mu); sum += sc[r]; }
    st.l = st.l * alpha + sum; st.m = mn;
    if (__builtin_amdgcn_ballot_w64(alpha != 1.0f) != 0ull) {
#pragma unroll
        for (int d0 = 0; d0 < 2; ++d0)
#pragma unroll
            for (int r = 0; r < 16; ++r) st.o[d0][r] *= alpha;
    }
    u32x4 w0, w1;
    w0.x = cvt_pk_bf16(sc[0], sc[1]); w0.y = cvt_pk_bf16(sc[2], sc[3]); w0.z = cvt_pk_bf16(sc[4], sc[5]); w0.w = cvt_pk_bf16(sc[6], sc[7]);
    w1.x = cvt_pk_bf16(sc[8], sc[9]); w1.y = cvt_pk_bf16(sc[10], sc[11]); w1.z = cvt_pk_bf16(sc[12], sc[13]); w1.w = cvt_pk_bf16(sc[14], sc[15]);
    const bf16x8 pb0 = __builtin_bit_cast(bf16x8, w0), pb1 = __builtin_bit_cast(bf16x8, w1);
    LAS const char* base = vb + (4 * hi + q4) * 64 + g1 * 32 + p4 * 8;
#pragma unroll
    for (int d0 = 0; d0 < 2; ++d0)
#pragma unroll
        for (int s2 = 0; s2 < 2; ++s2) { LAS const char* p = base + d0 * DHS + s2 * 1024; const s16x4 lo = trr(p), hh = trr(p + 512);
            st.o[d0] = __builtin_amdgcn_mfma_f32_32x32x16_bf16(cat8(lo, hh), s2 ? pb1 : pb0, st.o[d0], 0, 0, 0); }
}
__device__ __forceinline__ float attn_store(const AttnAcc& st, bf16_t* orow, int lane) {
    const int hi = lane >> 5; const float lt = xhalf_sum(st.l); const float inv = 1.0f / lt;
#pragma unroll
    for (int d0 = 0; d0 < 2; ++d0)
#pragma unroll
        for (int g4 = 0; g4 < 4; ++g4)
            *(u32x2*)(orow + 32 * d0 + 8 * g4 + 4 * hi) = (u32x2){cvt_pk_bf16(st.o[d0][4 * g4] * inv, st.o[d0][4 * g4 + 1] * inv), cvt_pk_bf16(st.o[d0][4 * g4 + 2] * inv, st.o[d0][4 * g4 + 3] * inv)};
    return lt;
}
constexpr float DSCALE = 16.0f;
__device__ __forceinline__ float attn_store_f8(const AttnAcc& st, unsigned char* orow, int lane) {
    const int hi = lane >> 5; const float lt = xhalf_sum(st.l); const float inv = DSCALE / lt;
#pragma unroll
    for (int d0 = 0; d0 < 2; ++d0)
#pragma unroll
        for (int g4 = 0; g4 < 4; ++g4)
            *(unsigned*)(orow + 32 * d0 + 8 * g4 + 4 * hi) = pg8::pk_fp8x4(st.o[d0][4 * g4] * inv, st.o[d0][4 * g4 + 1] * inv, st.o[d0][4 * g4 + 2] * inv, st.o[d0][4 * g4 + 3] * inv);
    return lt;
}
#define STAGE_V32(vbuf, ROWP) do { _Pragma("unroll") for (int _i = 0; _i < 4; ++_i) { const int _key = (lane >> 3) + 8 * _i, _ch = lane & 7; \
        const u32x4 _v = *(const u32x4*)((ROWP(_key)) + 8 * _ch); *(LAS u32x4*)((vbuf) + (_ch >> 2) * 2048 + _key * 64 + (_ch & 3) * 16) = _v; } } while (0)

template <int DHS>
__device__ __forceinline__ void attn_pair(AttnAcc& st, f32x16& s0, f32x16& s1, const bool has2, LAS const char* vb0, LAS const char* vb1, int lane) {
    const int hi = lane >> 5, g1 = (lane >> 4) & 1, q4 = (lane & 15) >> 2, p4 = lane & 3;
    const int voff = (4 * hi + q4) * 64 + g1 * 32 + p4 * 8;
    bf16x8 vfa[2][2], vfb[2][2];
#pragma unroll
    for (int d0 = 0; d0 < 2; ++d0)
#pragma unroll
        for (int s2 = 0; s2 < 2; ++s2) { LAS const char* p = vb0 + voff + d0 * DHS + s2 * 1024; vfa[d0][s2] = cat8(trr(p), trr(p + 512)); vfb[d0][s2] = vfa[d0][s2]; }
    if (has2) {
#pragma unroll
        for (int d0 = 0; d0 < 2; ++d0)
#pragma unroll
            for (int s2 = 0; s2 < 2; ++s2) { LAS const char* p = vb1 + voff + d0 * DHS + s2 * 1024; vfb[d0][s2] = cat8(trr(p), trr(p + 512)); }
    }
    __builtin_amdgcn_sched_barrier(0);
    float mx = s0[0];
#pragma unroll
    for (int r = 1; r < 16; ++r) mx = fmaxf(mx, s0[r]);
    if (has2) {
#pragma unroll
        for (int r = 0; r < 16; ++r) mx = fmaxf(mx, s1[r]);
    }
    mx = xhalf_max(mx);
    const float mn = fmaxf(st.m, mx);
    const float mu = (mn == -__builtin_inff()) ? 0.f : mn;
    const float alpha = __builtin_amdgcn_exp2f(st.m - mu);
    float sum = 0.f;
#pragma unroll
    for (int r = 0; r < 16; ++r) { s0[r] = __builtin_amdgcn_exp2f(s0[r] - mu); sum += s0[r]; }
    if (has2) {
#pragma unroll
        for (int r = 0; r < 16; ++r) { s1[r] = __builtin_amdgcn_exp2f(s1[r] - mu); sum += s1[r]; }
    }
    st.l = st.l * alpha + sum; st.m = mn;
    if (__builtin_amdgcn_ballot_w64(alpha != 1.0f) != 0ull) {
#pragma unroll
        for (int d0 = 0; d0 < 2; ++d0)
#pragma unroll
            for (int r = 0; r < 16; ++r) st.o[d0][r] *= alpha;
    }
    {
        u32x4 w0, w1;
        w0.x = cvt_pk_bf16(s0[0], s0[1]); w0.y = cvt_pk_bf16(s0[2], s0[3]); w0.z = cvt_pk_bf16(s0[4], s0[5]); w0.w = cvt_pk_bf16(s0[6], s0[7]);
        w1.x = cvt_pk_bf16(s0[8], s0[9]); w1.y = cvt_pk_bf16(s0[10], s0[11]); w1.z = cvt_pk_bf16(s0[12], s0[13]); w1.w = cvt_pk_bf16(s0[14], s0[15]);
        const bf16x8 pb0 = __builtin_bit_cast(bf16x8, w0), pb1 = __builtin_bit_cast(bf16x8, w1);
#pragma unroll
        for (int d0 = 0; d0 < 2; ++d0)
#pragma unroll
            for (int s2 = 0; s2 < 2; ++s2) st.o[d0] = __builtin_amdgcn_mfma_f32_32x32x16_bf16(vfa[d0][s2], s2 ? pb1 : pb0, st.o[d0], 0, 0, 0);
    }
    if (has2) {
        u32x4 w0, w1;
        w0.x = cvt_pk_bf16(s1[0], s1[1]); w0.y = cvt_pk_bf16(s1[2], s1[3]); w0.z = cvt_pk_bf16(s1[4], s1[5]); w0.w = cvt_pk_bf16(s1[6], s1[7]);
        w1.x = cvt_pk_bf16(s1[8], s1[9]); w1.y = cvt_pk_bf16(s1[10], s1[11]); w1.z = cvt_pk_bf16(s1[12], s1[13]); w1.w = cvt_pk_bf16(s1[14], s1[15]);
        const bf16x8 pb0 = __builtin_bit_cast(bf16x8, w0), pb1 = __builtin_bit_cast(bf16x8, w1);
#pragma unroll
        for (int d0 = 0; d0 < 2; ++d0)
#pragma unroll
            for (int s2 = 0; s2 < 2; ++s2) st.o[d0] = __builtin_amdgcn_mfma_f32_32x32x16_bf16(vfb[d0][s2], s2 ? pb1 : pb0, st.o[d0], 0, 0, 0);
    }
}
#define DMA_V32(ldsbuf, VROW) do { const bf16_t* _ra = (VROW(lane >> 2)) + (lane & 3) * 8; const bf16_t* _rb = (VROW(16 + (lane >> 2))) + (lane & 3) * 8; \
        __builtin_amdgcn_global_load_lds((const unsigned*)_ra, (LAS unsigned*)(ldsbuf), 16, 0, 0); \
        __builtin_amdgcn_global_load_lds((const unsigned*)_rb, (LAS unsigned*)((ldsbuf) + 1024), 16, 0, 0); \
        __builtin_amdgcn_global_load_lds((const unsigned*)(_ra + 32), (LAS unsigned*)((ldsbuf) + 2048), 16, 0, 0); \
        __builtin_amdgcn_global_load_lds((const unsigned*)(_rb + 32), (LAS unsigned*)((ldsbuf) + 3072), 16, 0, 0); } while (0)
#define CBAR() asm volatile("" ::: "memory")
#define WAIT_GROUP_V(nblk_next) do { if ((nblk_next) == 2) asm volatile("s_waitcnt vmcnt(16)" ::: "memory"); else if ((nblk_next) == 1) asm volatile("s_waitcnt vmcnt(8)" ::: "memory"); else asm volatile("s_waitcnt vmcnt(0)" ::: "memory"); } while (0)

__device__ __forceinline__ void phase_dilated(const Ctx& F, const Args& a) {
    unsigned char* ws = a.ws;
    const bf16_t* proj = (const bf16_t*)(ws + AR_PROJ); bf16_t* dilp = (bf16_t*)(ws + AR_DILP); float* dlse = (float*)(ws + AR_DLSE);
    const int gw = F.vcu * 8 + F.wave, NGW = F.G * 8, lane = F.lane, hi = lane >> 5, r32 = lane & 31;
    LAS char* vbuf = (LAS char*)F.lds + F.wave * 16384;
    const float sc2 = 0.125f * LOG2E;
    for (int u = gw; u < 3 * 4096; u += NGW) {
        const int br = u >> 12, v = u & 4095; const int dsh = 2 * br, d = 1 << dsh, sub = T >> dsh, nblk = sub >> 5;
        const int h = v & 7; int rest = v >> 3; const int sb = rest % nblk; rest /= nblk; const int rr = rest & (d - 1), b = rest >> dsh;
        const int s0 = 32 * sb; const size_t rowb = (size_t)b * T;
        const size_t rowq = rowb + (size_t)(s0 + r32) * d + rr;
        bf16x8 qf[4];
#pragma unroll
        for (int d0 = 0; d0 < 4; ++d0) qf[d0] = *(const bf16x8*)(proj + rowq * DINP + C_DLQ + h * 64 + 16 * d0 + 8 * hi);
        AttnAcc st; attn_init(st);
        const int kb_lo = (s0 < 64) ? ((64 - s0) >> 5) : 0; const int kb_hi = min(4, (sub - 1 - (s0 - 64)) >> 5);
        const int nb = kb_hi - kb_lo + 1, ng = (nb + 1) >> 1;
#define DIL_KROW(kb_, i) (rowb + (size_t)(s0 - 64 + 32 * (kb_) + (i)) * d + rr)
#define DIL_VROW0(k) (proj + DIL_KROW(kbA, (k)) * DINP + C_DLV + h * 64)
#define DIL_VROW1(k) (proj + DIL_KROW(kbA + 1, (k)) * DINP + C_DLV + h * 64)
#define DIL_ISSUE(g_, KF) do { const int kbA = kb_lo + 2 * (g_); const bool two_ = (kbA + 1 <= kb_hi); LAS char* vb_ = vbuf + ((g_) & 1) * 8192; \
            { const bf16_t* kp_ = proj + DIL_KROW(kbA, r32) * DINP + C_DLK + h * 64 + 8 * hi; _Pragma("unroll") for (int d0 = 0; d0 < 4; ++d0) KF[0][d0] = *(const bf16x8*)(kp_ + 16 * d0); } \
            DMA_V32(vb_, DIL_VROW0); \
            if (two_) { const bf16_t* kp_ = proj + DIL_KROW(kbA + 1, r32) * DINP + C_DLK + h * 64 + 8 * hi; _Pragma("unroll") for (int d0 = 0; d0 < 4; ++d0) KF[1][d0] = *(const bf16x8*)(kp_ + 16 * d0); \
                DMA_V32(vb_ + 4096, DIL_VROW1); } } while (0)
        bf16x8 kfn[2][4];
#pragma unroll
        for (int d0 = 0; d0 < 4; ++d0) kfn[1][d0] = kfn[0][d0] = (bf16x8){0, 0, 0, 0, 0, 0, 0, 0};
        CBAR(); DIL_ISSUE(0, kfn); CBAR();
#pragma unroll 1
        for (int g = 0; g < ng; ++g) {
            const int kbA = kb_lo + 2 * g; const bool has2 = (kbA + 1 <= kb_hi);
            bf16x8 kf[2][4];
#pragma unroll
            for (int d0 = 0; d0 < 4; ++d0) { kf[0][d0] = kfn[0][d0]; kf[1][d0] = kfn[1][d0]; }
            const int nnext = (g + 1 < ng) ? ((kbA + 3 <= kb_hi) ? 2 : 1) : 0;
            CBAR(); if (g + 1 < ng) DIL_ISSUE(g + 1, kfn); CBAR();
            f32x16 p0 = f32x16{}, p1 = f32x16{};
#pragma unroll
            for (int d0 = 0; d0 < 4; ++d0) p0 = __builtin_amdgcn_mfma_f32_32x32x16_bf16(kf[0][d0], qf[d0], p0, 0, 0, 0);
            if (has2) {
#pragma unroll
                for (int d0 = 0; d0 < 4; ++d0) p1 = __builtin_amdgcn_mfma_f32_32x32x16_bf16(kf[1][d0], qf[d0], p1, 0, 0, 0);
            }
#pragma unroll
            for (int r = 0; r < 16; ++r) { const int cr = crow(r, hi);
                const bool okA = (kbA == 0) ? (cr >= r32) : ((kbA == 4) ? (cr <= r32) : true); p0[r] = okA ? p0[r] * sc2 : -__builtin_inff();
                const bool okB = (kbA + 1 == 4) ? (cr <= r32) : true; p1[r] = okB ? p1[r] * sc2 : -__builtin_inff(); }
            WAIT_GROUP_V(nnext);
            attn_pair<2048>(st, p0, p1, has2, vbuf + (g & 1) * 8192, vbuf + (g & 1) * 8192 + 4096, lane);
            CBAR();
        }
#undef DIL_ISSUE
#undef DIL_VROW0
#undef DIL_VROW1
#undef DIL_KROW
        const float lt = attn_store_f8(st, (unsigned char*)dilp + ((size_t)br * M + rowq) * 512 + h * 64, lane);
        if (hi == 0) dlse[((size_t)br * M + rowq) * 8 + h] = (st.m + __log2f(lt)) * (1.0f / LOG2E);
    }
}

__device__ __forceinline__ void phase_na(const Ctx& F, const Args& a, int l) {
    unsigned char* ws = a.ws;
    const bf16_t* proj = (const bf16_t*)(ws + AR_PROJ); bf16_t* mixed = (bf16_t*)(ws + AR_MIXED);
    const int gw = F.vcu * 8 + F.wave, NGW = F.G * 8, lane = F.lane, hi = lane >> 5, r32 = lane & 31;
    LAS char* vbuf = (LAS char*)F.lds + F.wave * 16384;
    LAS float* rpbL = (LAS float*)(F.lds + 131072);
    { const float* rpb = a.in[I_NA_RPB] + (size_t)l * 8 * 15 * 31;
      for (int i = F.tid; i < 8 * 15 * 32; i += 512) { const int c = i & 31, hr = i >> 5; rpbL[i] = c < 31 ? rpb[hr * 31 + c] * LOG2E : 0.f; } }
    __syncthreads();
    const float sc2 = 0.125f * LOG2E;
    for (int u = gw; u < 4096; u += NGW) {
        const int h = u & 7, cb = (u >> 3) & 3, rp = (u >> 5) & 31, b = u >> 10;
        const int qrow = 2 * rp + (r32 >> 4), qc = 16 * cb + (r32 & 15); const size_t rowq = (size_t)b * T + qrow * 64 + qc;
        const int qs = min(max(qc - 8, 0), 48), rsq = min(max(qrow - 4, 0), 56);
        const int c0 = min(max(16 * cb - 8, 0), 32), rs0 = min(max(2 * rp - 4, 0), 56), rs1 = min(max(2 * rp - 3, 0), 56);
        const int nb = 8 + (rs1 - rs0), ng = (nb + 1) >> 1;
        bf16x8 qf[4];
#pragma unroll
        for (int d0 = 0; d0 < 4; ++d0) qf[d0] = *(const bf16x8*)(proj + rowq * DINP + C_NAQ + h * 64 + 16 * d0 + 8 * hi);
        AttnAcc st; attn_init(st);
        const size_t rowk0 = (size_t)b * T + rs0 * 64 + c0;
        const int cbase = c0 + 4 * hi - qs;
        const int bbase = c0 + 4 * hi - qc + 15;
#define NA_VROW0(k) (proj + (rowk0 + 64 * jA + (k)) * DINP + C_NAV + h * 64)
#define NA_VROW1(k) (proj + (rowk0 + 64 * (jA + 1) + (k)) * DINP + C_NAV + h * 64)
#define NA_ISSUE(g_, KF) do { const int jA = 2 * (g_); const bool two_ = (jA + 1 < nb); LAS char* vb_ = vbuf + ((g_) & 1) * 8192; \
            { const bf16_t* kp_ = proj + (rowk0 + 64 * jA + r32) * DINP + C_NAK + h * 64 + 8 * hi; _Pragma("unroll") for (int d0 = 0; d0 < 4; ++d0) KF[0][d0] = *(const bf16x8*)(kp_ + 16 * d0); } \
            DMA_V32(vb_, NA_VROW0); \
            if (two_) { const bf16_t* kp_ = proj + (rowk0 + 64 * (jA + 1) + r32) * DINP + C_NAK + h * 64 + 8 * hi; _Pragma("unroll") for (int d0 = 0; d0 < 4; ++d0) KF[1][d0] = *(const bf16x8*)(kp_ + 16 * d0); \
                DMA_V32(vb_ + 4096, NA_VROW1); } } while (0)
        bf16x8 kfn[2][4];
#pragma unroll
        for (int d0 = 0; d0 < 4; ++d0) kfn[1][d0] = kfn[0][d0] = (bf16x8){0, 0, 0, 0, 0, 0, 0, 0};
        CBAR(); NA_ISSUE(0, kfn); CBAR();
#pragma unroll 1
        for (int g = 0; g < ng; ++g) {
            const int jA = 2 * g; const bool has2 = (jA + 1 < nb);
            bf16x8 kf[2][4];
#pragma unroll
            for (int d0 = 0; d0 < 4; ++d0) { kf[0][d0] = kfn[0][d0]; kf[1][d0] = kfn[1][d0]; }
            const int nnext = (g + 1 < ng) ? ((jA + 3 < nb) ? 2 : 1) : 0;
            CBAR(); if (g + 1 < ng) NA_ISSUE(g + 1, kfn); CBAR();
            f32x16 p0 = f32x16{}, p1 = f32x16{};
#pragma unroll
            for (int d0 = 0; d0 < 4; ++d0) p0 = __builtin_amdgcn_mfma_f32_32x32x16_bf16(kf[0][d0], qf[d0], p0, 0, 0, 0);
            if (has2) {
#pragma unroll
                for (int d0 = 0; d0 < 4; ++d0) p1 = __builtin_amdgcn_mfma_f32_32x32x16_bf16(kf[1][d0], qf[d0], p1, 0, 0, 0);
            }
            const int krA = rs0 + jA; const bool rowA = (unsigned)(krA - rsq) < 8u, rowB = (unsigned)(krA + 1 - rsq) < 8u;
            const int roA = min(max(krA - qrow + 7, 0), 14), roB = min(max(krA + 1 - qrow + 7, 0), 14);
            LAS const float* bA = rpbL + (h * 15 + roA) * 32; LAS const float* bB = rpbL + (h * 15 + roB) * 32;
#pragma unroll
            for (int r = 0; r < 16; ++r) { const int cr = (r & 3) + 8 * (r >> 2); const bool colok = (unsigned)(cbase + cr) < 16u; const int bc = min(max(bbase + cr, 0), 30);
                p0[r] = (colok && rowA) ? (p0[r] * sc2 + bA[bc]) : -__builtin_inff();
                p1[r] = (colok && rowB) ? (p1[r] * sc2 + bB[bc]) : -__builtin_inff(); }
            WAIT_GROUP_V(nnext);
            attn_pair<2048>(st, p0, p1, has2, vbuf + (g & 1) * 8192, vbuf + (g & 1) * 8192 + 4096, lane);
            CBAR();
        }
#undef NA_ISSUE
#undef NA_VROW0
#undef NA_VROW1
        (void)attn_store(st, mixed + rowq * D + 512 + h * 64, lane);
    }
    __syncthreads();
}

#ifndef MLA_THR
#define MLA_THR 8.0f
#endif
__device__ __forceinline__ float max3f_(float a, float b, float c) { return __builtin_fmaxf(__builtin_fmaxf(a, b), c); }
__device__ __forceinline__ void mla_tile(AttnAcc& st, float& mhat, f32x16& negm, f32x16& p0, f32x16& p1, const bool first, const bf16x8 (&vf)[2][2][2]) {
    float a = max3f_(p0[0], p0[1], p1[0]), b = max3f_(p0[2], p0[3], p1[1]); a = max3f_(a, p1[2], p1[3]);
#pragma unroll
    for (int r = 4; r < 16; r += 4) { a = max3f_(a, p0[r], p0[r + 1]); b = max3f_(b, p0[r + 2], p0[r + 3]); a = max3f_(a, p1[r], p1[r + 1]); b = max3f_(b, p1[r + 2], p1[r + 3]); }
    const float rm = xhalf_max(__builtin_fmaxf(a, b));
    if (first || __builtin_amdgcn_ballot_w64(rm > MLA_THR) != 0ull) {
        const float dl = first ? rm : __builtin_fmaxf(rm, 0.f);
        mhat += dl;
#pragma unroll
        for (int r = 0; r < 16; ++r) { p0[r] -= dl; p1[r] -= dl; negm[r] = -mhat; }
        asm volatile("" : "+v"(negm));
        if (!first) { const float f = __builtin_amdgcn_exp2f(-dl); st.l *= f;
#pragma unroll
            for (int d0 = 0; d0 < 2; ++d0)
#pragma unroll
                for (int r = 0; r < 16; ++r) st.o[d0][r] *= f; }
    }
    float sum = 0.f;
#pragma unroll
    for (int r = 0; r < 16; ++r) { p0[r] = __builtin_amdgcn_exp2f(p0[r]); p1[r] = __builtin_amdgcn_exp2f(p1[r]); sum += p0[r] + p1[r]; }
    st.l += sum;
#pragma unroll
    for (int blk = 0; blk < 2; ++blk) { const f32x16& s = blk ? p1 : p0;
        u32x4 w0, w1;
        w0.x = cvt_pk_bf16(s[0], s[1]); w0.y = cvt_pk_bf16(s[2], s[3]); w0.z = cvt_pk_bf16(s[4], s[5]); w0.w = cvt_pk_bf16(s[6], s[7]);
        w1.x = cvt_pk_bf16(s[8], s[9]); w1.y = cvt_pk_bf16(s[10], s[11]); w1.z = cvt_pk_bf16(s[12], s[13]); w1.w = cvt_pk_bf16(s[14], s[15]);
        const bf16x8 pb0 = __builtin_bit_cast(bf16x8, w0), pb1 = __builtin_bit_cast(bf16x8, w1);
#pragma unroll
        for (int d0 = 0; d0 < 2; ++d0)
#pragma unroll
            for (int s2 = 0; s2 < 2; ++s2) st.o[d0] = __builtin_amdgcn_mfma_f32_32x32x16_bf16(vf[blk][d0][s2], s2 ? pb1 : pb0, st.o[d0], 0, 0, 0); }
}
__device__ __forceinline__ void phase_mla(const Ctx& F, const Args& a, const int conv_list, const int conv_every) {
    unsigned char* ws = a.ws;
    const bf16_t* proj = (const bf16_t*)(ws + AR_PROJ); const bf16_t* qm = (const bf16_t*)(ws + AR_QMLA); const bf16_t* kv = qm + 768;   bf16_t* mixed = (bf16_t*)(ws + AR_MIXED);
    const f32x2* rope = (const f32x2*)(ws + WS_ROPE);
    const int lane = F.lane, wave = F.wave, tid = F.tid, hi = lane >> 5, r32 = lane & 31;
    LAS char* lds = (LAS char*)F.lds;
    constexpr int KB = 12288, VB = 8192, VOFF = 2 * KB;
    const float qscale = 0.10206207261596577f * LOG2E;
    LAS float* cscr = (LAS float*)(lds + 65536 + wave * 8448);
    const int cstride = F.G * 8; int cit = F.vcu * 8 + wave; ConvJob cj; f32x4 cv[8]; bool cpend = false; int ctick = 0;
#pragma unroll
    for (int i = 0; i < 8; ++i) cv[i] = (f32x4){0.f, 0.f, 0.f, 0.f};
    for (int u = F.vcu; u < NB * 8 * 16; u += F.G) {
        const int bh = u >> 4, qb = u & 15, b = bh >> 3, h = bh & 7;
        const size_t rowb = (size_t)b * T; const int tq = qb * 256 + wave * 32 + r32; const size_t rowq = rowb + tq;
        bf16x8 qf[6];
        {
            float qv[6][8]; u32x4 qraw[6]; f32x2 csr[8];
#pragma unroll
            for (int d0 = 0; d0 < 6; ++d0) qraw[d0] = *(const u32x4*)(qm + rowq * 1792 + h * 96 + 16 * d0 + 8 * hi);
#pragma unroll
            for (int j = 0; j < 8; ++j) csr[j] = rope[(size_t)tq * 32 + 2 * (8 * hi + j)];
            __builtin_amdgcn_sched_barrier(0);
#pragma unroll
            for (int d0 = 0; d0 < 6; ++d0) { const unsigned xs[4] = {qraw[d0].x, qraw[d0].y, qraw[d0].z, qraw[d0].w};
#pragma unroll
                for (int j = 0; j < 4; ++j) { qv[d0][2 * j] = bf_lo(xs[j]); qv[d0][2 * j + 1] = bf_hi(xs[j]); } }
#pragma unroll
            for (int j = 0; j < 8; ++j) { const f32x2 cs = csr[j]; const float x1 = qv[4][j], x2 = qv[5][j]; qv[4][j] = x1 * cs.x - x2 * cs.y; qv[5][j] = x2 * cs.x + x1 * cs.y; }
#pragma unroll
            for (int d0 = 0; d0 < 6; ++d0) { u32x4 w; w.x = cvt_pk_bf16(qv[d0][0] * qscale, qv[d0][1] * qscale); w.y = cvt_pk_bf16(qv[d0][2] * qscale, qv[d0][3] * qscale);
                w.z = cvt_pk_bf16(qv[d0][4] * qscale, qv[d0][5] * qscale); w.w = cvt_pk_bf16(qv[d0][6] * qscale, qv[d0][7] * qscale); qf[d0] = __builtin_bit_cast(bf16x8, w); }
        }
        AttnAcc st; attn_init(st); float mhat = 0.f; f32x16 negm = f32x16{};
        const int key8 = tid >> 3, c8 = tid & 7, key4 = tid >> 2, c4 = tid & 3;
        const bf16_t* ksrc = kv + (rowb + key8) * 1792 + h * 128 + 8 * c8;
        const bf16_t* vsrc = ksrc + 64;
        const bf16_t* psrc = proj + (rowb + key4) * DINP + C_KR + 8 * c4;
        const int kdst = c8 * 1024 + key8 * 16, pdst = (8 + c4) * 1024 + key4 * 16, vdst = VOFF + (c8 >> 2) * 4096 + key8 * 64 + (c8 & 3) * 16;
        u32x4 kr0, kr1 = (u32x4){0u, 0u, 0u, 0u}, vr;
        kr0 = *(const u32x4*)ksrc; vr = *(const u32x4*)vsrc; if (tid < 256) kr1 = *(const u32x4*)psrc;
        *(LAS u32x4*)(lds + kdst) = kr0; *(LAS u32x4*)(lds + vdst) = vr; if (tid < 256) *(LAS u32x4*)(lds + pdst) = kr1;
        __syncthreads();
#pragma unroll 1
        for (int t = 0; t < 64; ++t) {
            const int cur = t & 1;
            if (t + 1 < 64) { const size_t o = (size_t)(t + 1) * 64; kr0 = *(const u32x4*)(ksrc + o * 1792); vr = *(const u32x4*)(vsrc + o * 1792); if (tid < 256) kr1 = *(const u32x4*)(psrc + o * DINP); }
            LAS const char* kb = lds + cur * KB; LAS const char* vb = lds + VOFF + cur * VB;
            {
                bf16x8 kfa[6], kfb[6];
#pragma unroll
                for (int d0 = 0; d0 < 6; ++d0) { kfa[d0] = *(LAS const bf16x8*)(kb + (2 * d0 + hi) * 1024 + r32 * 16); kfb[d0] = *(LAS const bf16x8*)(kb + (2 * d0 + hi) * 1024 + (32 + r32) * 16); }
                __builtin_amdgcn_sched_barrier(0);
                f32x16 p0 = negm, p1 = negm;
#pragma unroll
                for (int d0 = 0; d0 < 6; ++d0) { p0 = __builtin_amdgcn_mfma_f32_32x32x16_bf16(kfa[d0], qf[d0], p0, 0, 0, 0); p1 = __builtin_amdgcn_mfma_f32_32x32x16_bf16(kfb[d0], qf[d0], p1, 0, 0, 0); }
                __builtin_amdgcn_sched_barrier(0);
                bf16x8 vf[2][2][2];
                { const int g1 = (lane >> 4) & 1, q4 = (lane & 15) >> 2, p4 = lane & 3; LAS const char* vbase = vb + (4 * hi + q4) * 64 + g1 * 32 + p4 * 8;
#pragma unroll
                  for (int blk = 0; blk < 2; ++blk)
#pragma unroll
                    for (int d0 = 0; d0 < 2; ++d0)
#pragma unroll
                        for (int s2 = 0; s2 < 2; ++s2) { LAS const char* pp = vbase + blk * 2048 + d0 * 4096 + s2 * 1024; vf[blk][d0][s2] = cat8(trr(pp), trr(pp + 512)); } }
                __builtin_amdgcn_sched_barrier(0);
                mla_tile(st, mhat, negm, p0, p1, t == 0, vf);
            }
            if (t + 1 < 64) { const int nx = (cur ^ 1); *(LAS u32x4*)(lds + nx * KB + kdst) = kr0; *(LAS u32x4*)(lds + nx * VB + vdst) = vr; if (tid < 256) *(LAS u32x4*)(lds + nx * KB + pdst) = kr1; }
            if (++ctick >= conv_every) { ctick = 0;
                if (cpend) { conv_finish(cj, cv, cscr, lane); cpend = false; cit += cstride; }
                if (conv_decode(a, conv_list, cit, cj)) { conv_issue(cj, cv, lane); cpend = true; } }
            __syncthreads();
        }
        (void)attn_store(st, mixed + rowq * D + 1024 + h * 64, lane);
    }
    for (;;) { if (cpend) { conv_finish(cj, cv, cscr, lane); cpend = false; cit += cstride; }
        if (!conv_decode(a, conv_list, cit, cj)) break; conv_issue(cj, cv, lane); cpend = true; }
}

__device__ __forceinline__ void phase_dilated_wg(const Ctx& F, const Args& a) {
    unsigned char* ws = a.ws;
    const bf16_t* proj = (const bf16_t*)(ws + AR_PROJ); bf16_t* dilp = (bf16_t*)(ws + AR_DILP); float* dlse = (float*)(ws + AR_DLSE);
    const int lane = F.lane, wave = F.wave, hi = lane >> 5, r32 = lane & 31, g1 = (lane >> 4) & 1, q4 = (lane & 15) >> 2, p4 = lane & 3;
    LAS char* kimg = (LAS char*)F.lds; LAS char* vimg = kimg + 49152;
    const float sc2 = 0.125f * LOG2E;
    for (int u = F.bx; u < 3 * 512; u += F.G) {
        const int br = u >> 9, v = u & 511; const int dsh = 2 * br, d = 1 << dsh, sub = T >> dsh, nsb = sub >> 8;
        const int h = v & 7; int rest = v >> 3; const int SB = rest % nsb; rest /= nsb; const int rr = rest & (d - 1), b = rest >> dsh;
        const size_t rowb = (size_t)b * T; const int sbase = 256 * SB - 64;
        CBAR();
#pragma unroll
        for (int i = 0; i < 6; ++i) { const int piece = wave + 8 * i; const int m0 = 8 * piece; const int s_first = sbase + (m0 & ~31);
            if (s_first >= 0 && s_first < sub) { const int m = m0 + (lane >> 3); const int cg = (lane & 7) ^ (m & 7);
                const bf16_t* rp = proj + (rowb + (size_t)(sbase + m) * d + rr) * DINP + h * 64 + cg * 8;
                __builtin_amdgcn_global_load_lds((const unsigned*)(rp + C_DLK), (LAS unsigned*)(kimg + m0 * 128), 16, 0, 0);
                __builtin_amdgcn_global_load_lds((const unsigned*)(rp + C_DLV), (LAS unsigned*)(vimg + m0 * 128), 16, 0, 0); } }
        CBAR();
        const int s0 = 256 * SB + 32 * wave; const size_t rowq = rowb + (size_t)(s0 + r32) * d + rr;
        bf16x8 qf[4];
#pragma unroll
        for (int d0 = 0; d0 < 4; ++d0) qf[d0] = *(const bf16x8*)(proj + rowq * DINP + C_DLQ + h * 64 + 16 * d0 + 8 * hi);
        AttnAcc st; attn_init(st);
        const int kb_lo = (s0 < 64) ? ((64 - s0) >> 5) : 0; const int kb_hi = min(4, (sub - 1 - (s0 - 64)) >> 5);
        asm volatile("s_waitcnt vmcnt(0)" ::: "memory");
        __syncthreads();
#pragma unroll 1
        for (int kb = kb_lo; kb <= kb_hi; ++kb) {
            const int mrow = 32 * wave + 32 * kb + r32;
            bf16x8 kf[4], vf[2][2]; const int mblk = 32 * wave + 32 * kb;
#pragma unroll
            for (int d0 = 0; d0 < 4; ++d0) kf[d0] = *(LAS const bf16x8*)(kimg + mrow * 128 + (((2 * d0 + hi) ^ (mrow & 7)) * 16));
#pragma unroll
            for (int d0 = 0; d0 < 2; ++d0)
#pragma unroll
                for (int s2 = 0; s2 < 2; ++s2) { const int key = mblk + 16 * s2 + 4 * hi + q4; const int cchunk = 4 * d0 + 2 * g1 + (p4 >> 1);
                    vf[d0][s2] = cat8(trr(vimg + key * 128 + ((cchunk ^ (key & 7)) * 16) + (p4 & 1) * 8), trr(vimg + (key + 8) * 128 + ((cchunk ^ ((key + 8) & 7)) * 16) + (p4 & 1) * 8)); }
            __builtin_amdgcn_sched_barrier(0);
            f32x16 p = f32x16{};
#pragma unroll
            for (int d0 = 0; d0 < 4; ++d0) p = __builtin_amdgcn_mfma_f32_32x32x16_bf16(kf[d0], qf[d0], p, 0, 0, 0);
#pragma unroll
            for (int r = 0; r < 16; ++r) { const int cr = crow(r, hi); const bool ok = (kb == 0) ? (cr >= r32) : ((kb == 4) ? (cr <= r32) : true); p[r] = ok ? p[r] * sc2 : -__builtin_inff(); }
            float mx = p[0];
#pragma unroll
            for (int r = 1; r < 16; ++r) mx = fmaxf(mx, p[r]);
            mx = xhalf_max(mx);
            const float mn = fmaxf(st.m, mx); const float mu = (mn == -__builtin_inff()) ? 0.f : mn; const float alpha = __builtin_amdgcn_exp2f(st.m - mu);
            float sum = 0.f;
#pragma unroll
            for (int r = 0; r < 16; ++r) { p[r] = __builtin_amdgcn_exp2f(p[r] - mu); sum += p[r]; }
            st.l = st.l * alpha + sum; st.m = mn;
            if (__builtin_amdgcn_ballot_w64(alpha != 1.0f) != 0ull) {
#pragma unroll
                for (int d0 = 0; d0 < 2; ++d0)
#pragma unroll
                    for (int r = 0; r < 16; ++r) st.o[d0][r] *= alpha; }
            u32x4 w0, w1;
            w0.x = cvt_pk_bf16(p[0], p[1]); w0.y = cvt_pk_bf16(p[2], p[3]); w0.z = cvt_pk_bf16(p[4], p[5]); w0.w = cvt_pk_bf16(p[6], p[7]);
            w1.x = cvt_pk_bf16(p[8], p[9]); w1.y = cvt_pk_bf16(p[10], p[11]); w1.z = cvt_pk_bf16(p[12], p[13]); w1.w = cvt_pk_bf16(p[14], p[15]);
            const bf16x8 pb0 = __builtin_bit_cast(bf16x8, w0), pb1 = __builtin_bit_cast(bf16x8, w1);
#pragma unroll
            for (int d0 = 0; d0 < 2; ++d0)
#pragma unroll
                for (int s2 = 0; s2 < 2; ++s2) st.o[d0] = __builtin_amdgcn_mfma_f32_32x32x16_bf16(vf[d0][s2], s2 ? pb1 : pb0, st.o[d0], 0, 0, 0);
        }
        const float lt = attn_store_f8(st, (unsigned char*)dilp + ((size_t)br * M + rowq) * 512 + h * 64, lane);
        if (hi == 0) dlse[((size_t)br * M + rowq) * 8 + h] = (st.m + __log2f(lt)) * (1.0f / LOG2E);
        __syncthreads();
    }
}

__device__ __forceinline__ void phase_moe_gather(const Ctx& F, const Args& a) {
    unsigned char* ws = a.ws;
    const int* histo = (const int*)(ws + WS_HISTO); int* tpg = (int*)(ws + WS_TP); int* rowtok = (int*)(ws + WS_ROWTOK); float* rowgate = (float*)(ws + WS_ROWGATE);
    const bf16_t* H = (const bf16_t*)(ws + WS_H); unsigned char* HG = ws + AR_HG;
    LAS int* tot = (LAS int*)F.lds; LAS int* base = tot + 8; LAS int* seg = tot + 16; LAS int* slots = tot + 32;
    const int lane = F.lane, wave = F.wave, w = F.bx, rows_per_wg = M / F.G;
    {
        const int e = wave; int t = 0, bsum = 0;
        for (int j = lane; j < F.G; j += 64) { const int c = histo[j * 8 + e]; t += c; if (j < w) bsum += c; }
        t = wave_sum_i(t); bsum = wave_sum_i(bsum);
        if (lane == 0) { tot[e] = t; base[e] = bsum; }
    }
    __syncthreads();
    if (F.tid == 0) { int p = 0; for (int e = 0; e < 8; ++e) { seg[e] = p; p += (tot[e] + 255) >> 8; } seg[8] = p; if (w == 0) { for (int e = 0; e <= 8; ++e) tpg[e] = seg[e]; } }
    __syncthreads();
    if (wave == 0) {
        const bool act = lane < rows_per_wg; const int m = w * rows_per_wg + lane;
        u32x4 rt = (u32x4){0u, 0u, 0u, 0u}; if (act) rt = ((const u32x4*)(ws + WS_ROUTE))[m];
        const int ek[2] = {act ? (int)rt.x : -1, act ? (int)rt.y : -1}; const float gk[2] = {__uint_as_float(rt.z), __uint_as_float(rt.w)};
        int run[8];
#pragma unroll
        for (int e = 0; e < 8; ++e) run[e] = 0;
#pragma unroll
        for (int k = 0; k < 2; ++k)
#pragma unroll
            for (int e = 0; e < 8; ++e) { const unsigned long long mask = __ballot(ek[k] == e);
                if (ek[k] == e) { const int rank = __popcll(mask & ((1ull << lane) - 1ull)); const int slot = 256 * seg[e] + base[e] + run[e] + rank;
                    rowtok[slot] = m + k * M; rowgate[slot] = gk[k]; slots[lane * 2 + k] = slot; }
                run[e] += __popcll(mask); }
    }
    __syncthreads();
    if (w < 8) { const int e = w, r0 = 256 * seg[e] + tot[e], r1 = 256 * seg[e + 1];
        for (int r = r0 + F.tid; r < r1; r += 512) { rowtok[r] = -1; rowgate[r] = 0.f; } }
    __syncthreads();
}
template <int WGMT, bool GATHERF>
struct MoeSched {
    static constexpr bool GATHER = GATHERF;
    int tp[9]; int nN, G, c; const char* A; const char* B; size_t tA, tB, eB; const int* rowtok;
    __device__ __forceinline__ bool next(int i, pg8::Unit& u) const {
        if (!pg8::tile_of<WGMT>(i, G, c, tp[8], nN, u.pm, u.pn)) return false;
        int e = 0;
#pragma unroll
        for (int j = 1; j < 8; ++j) e += (u.pm >= tp[j]) ? 1 : 0;
        u.e = e; u.a = GATHERF ? A : A + (size_t)u.pm * tA; u.b = B + (size_t)e * eB + (size_t)u.pn * tB; return true;
    }
    __device__ __forceinline__ void gather(const pg8::Unit& u, int tid, unsigned (&off)[2][2]) const {
#pragma unroll
        for (int i = 0; i < 2; ++i) { int R, C; pg8::stage_rc(tid * 16 + i * 8192, R, C);
#pragma unroll
            for (int h = 0; h < 2; ++h) { const int rt = rowtok[u.pm * 256 + h * 128 + R]; const int tok = rt < 0 ? M : (rt >= M ? rt - M : rt); off[h][i] = (unsigned)tok * (unsigned)D + (unsigned)C * 2u; } }
    }
};

#ifndef WGM_INPROJ
#define WGM_INPROJ 8
#endif
#ifndef WGM_OUTPROJ
#define WGM_OUTPROJ 4
#endif
#ifndef WGM_GU
#define WGM_GU 8
#endif
#ifndef WGM_DOWN
#define WGM_DOWN 4
#endif
#ifndef WGM_MOEGU
#define WGM_MOEGU 16
#endif
#ifndef WGM_MOEDN
#define WGM_MOEDN 4
#endif
#ifndef WGM_MLAUP
#define WGM_MLAUP 4
#endif
#ifndef CONV_E0
#define CONV_E0 2
#endif
#ifndef CONV_E1
#define CONV_E1 3
#endif
#ifndef PH_MASK
#define PH_MASK 0xFFFFFFFFu
#endif
#ifndef REP_MASK
#define REP_MASK 0u
#endif
typedef const __attribute__((address_space(4))) Args KArgs;
__device__ __forceinline__ void load_args(KArgs* p, Args& a) {
#pragma unroll
    for (int i = 0; i < 24; ++i) a.in[i] = p->in[i];
    a.out = p->out; a.ws = p->ws; a.ph_lo = p->ph_lo; a.ph_hi = p->ph_hi;
}
#define PHASE_BEGIN(k) if (ph >= lo && ph < hi) { if ((PH_MASK >> (k)) & 1) for (int rep_ = 0; rep_ <= (int)((REP_MASK >> (k)) & 1u); ++rep_) { if (rep_) __syncthreads(); \
        Ctx F = F0; asm volatile("" : "+v"(F.tid)); F.lane = F.tid & 63; F.wave = __builtin_amdgcn_readfirstlane(F.tid >> 6); \
        KArgs* kp_ = ka; asm volatile("" : "+s"(kp_)); Args args; load_args(kp_, args); unsigned char* ws = args.ws; (void)ws;
#define RELAUNDER() do { asm volatile("" : "+v"(F.tid)); F.lane = F.tid & 63; F.wave = __builtin_amdgcn_readfirstlane(F.tid >> 6); KArgs* kp2_ = ka; asm volatile("" : "+s"(kp2_)); load_args(kp2_, args); ws = args.ws; } while (0)
#define PHASE_END   } if (ph + 1 < hi) xcd_barrier(bar); } ++ph;
#define X ((bf16_t*)(ws + WS_X))
#define H ((bf16_t*)(ws + WS_H))
#define PROJ ((bf16_t*)(ws + AR_PROJ))
#define MIXED ((bf16_t*)(ws + AR_MIXED))

template <int L>
__device__ __forceinline__ void layer_phases(const Ctx& F0, KArgs* ka, const XcdBarrier& bar, const int lo, const int hi, int& ph) {
    constexpr int l = L;

        if (l > 0 && !(NORM_FOLD && STATS_FUSED)) {
        PHASE_BEGIN(1)
#if NORM_FOLD
            phase_rowstats(F, X, (float*)(ws + WS_RSTD));
#else
            phase_rmsnorm_bf16(F, X, args.in[I_ATTN_NORM] + (size_t)l * D, H);
#endif
        PHASE_END
        } else ++ph;
        PHASE_BEGIN(2)
            if constexpr (NORM_FOLD && STATS_FUSED && l > 0) {
                pg8::Gemm g{D, D, D}; pg8::PlainSched<WGM_INPROJ> S{M / 256, DINP / 256, F.G, F.bx, (const char*)X, (const char*)(ws + WS_WIN + l * SZ_WIN), (size_t)256 * D * 2, (size_t)256 * D * 2};
                { const int mu = (S.nM * S.nN + F.G - 1) / F.G; pg8::fill_lrs(S, (const float*)(ws + WS_PART), F.lds, F.tid, mu < 23 ? mu : 23); }
                pg8::EpiBf16RL E{PROJ, DINP, (LAS const float*)(F.lds + pg8::LDS_LRS_OFF)};
                pg8::gemm_phase<false>(F.lds, F.tid, g, S, E);
            } else if constexpr (NORM_FOLD) {
                pg8::Gemm g{D, D, D}; pg8::PlainSched<WGM_INPROJ> S{M / 256, DINP / 256, F.G, F.bx, (const char*)X, (const char*)(ws + WS_WIN + l * SZ_WIN), (size_t)256 * D * 2, (size_t)256 * D * 2};
                pg8::EpiBf16R E{PROJ, DINP, (const float*)(ws + WS_RSTD)};
                pg8::gemm_phase<false>(F.lds, F.tid, g, S, E);
            } else {
                pg8::Gemm g{D, D, D}; pg8::PlainSched<WGM_INPROJ> S{M / 256, DINP / 256, F.G, F.bx, (const char*)H, (const char*)(ws + WS_WIN + l * SZ_WIN), (size_t)256 * D * 2, (size_t)256 * D * 2};
                pg8::EpiBf16 E{PROJ, DINP};
                pg8::gemm_phase<false>(F.lds, F.tid, g, S, E);
            }
        PHASE_END
        PHASE_BEGIN(3)
            phase_token_local(F, args, l);
#ifdef REP3
            RELAUNDER(); phase_token_local(F, args, l, true);
#endif
        PHASE_END
        PHASE_BEGIN(4)
            {
                struct MlaSched { enum { GATHER = 0 }; int G, c; const char* A; const char* B;
                    __device__ __forceinline__ void gather(const pg8::Unit&, int, unsigned (&)[2][2]) const {}
                    __device__ __forceinline__ bool next(int i, pg8::Unit& u) const { if (!pg8::tile_of<WGM_MLAUP>(i, G, c, M / 256, 7, u.pm, u.pn)) return false; u.e = 0;
                        u.a = A + (size_t)u.pm * 256 * DINP * 2 + (u.pn < 3 ? C_CQ : C_CKV) * 2; u.b = B + (size_t)u.pn * 256 * 512 * 2; return true; } };
                pg8::Gemm g{DINP, 512, 512}; MlaSched S{F.G, F.bx, (const char*)PROJ, (const char*)(ws + WS_WUQKV + l * SZ_WUQKV)};
#if NORM_FOLD
                pg8::EpiBf16R2 E{(bf16_t*)(ws + AR_QMLA), 1792, (const float*)(ws + WS_RSTD2)};
#else
                pg8::EpiBf16 E{(bf16_t*)(ws + AR_QMLA), 1792};
#endif
                pg8::gemm_phase<false>(F.lds, F.tid, g, S, E);
            }
            __syncthreads(); RELAUNDER();
            phase_ssm_states(F, args, l);
#ifdef REP4B
            __syncthreads(); RELAUNDER(); phase_ssm_states(F, args, l);
#endif
            __syncthreads(); RELAUNDER();
            phase_na(F, args, l);
#ifdef REP4C
            __syncthreads(); RELAUNDER(); phase_na(F, args, l);
#endif
            RELAUNDER();
#ifdef DIL_WAVE
            phase_dilated(F, args);
#else
            __syncthreads(); phase_dilated_wg(F, args);
#endif
#ifdef REP4D
            __syncthreads(); RELAUNDER(); phase_dilated_wg(F, args);
#endif
        PHASE_END
        PHASE_BEGIN(5)
            phase_ssm_scan(F, args);
            __syncthreads(); RELAUNDER();
            phase_mla(F, args, l, l == 0 ? CONV_E0 : CONV_E1);
        PHASE_END
        PHASE_BEGIN(6)
            phase_ssm_out(F, args, l);
            RELAUNDER();
            phase_dil_merge(F, args);
        PHASE_END
        PHASE_BEGIN(7)
            pg8::Gemm g{D, D, D}; pg8::PlainSched<WGM_OUTPROJ> S{M / 256, D / 256, F.G, F.bx, (const char*)MIXED, (const char*)(ws + WS_WO + l * SZ_WO), (size_t)256 * D * 2, (size_t)256 * D * 2};
            if constexpr (l == 0 && !NORM_FOLD) { pg8::EpiResB16<float> E{args.in[I_X], X, 1.0f}; pg8::gemm_phase<false>(F.lds, F.tid, g, S, E); }
            else if constexpr (l == 0 && NORM_FOLD && STATS_FUSED) { pg8::EpiResB16S E{X, X, 1.0f, (float*)(ws + WS_PART), (LAS float*)(F.lds + pg8::LDS_SS_OFF)}; pg8::gemm_phase<false>(F.lds, F.tid, g, S, E); }
            else { pg8::EpiResB16<bf16_t> E{X, X, 1.0f}; pg8::gemm_phase<false>(F.lds, F.tid, g, S, E); }
        PHASE_END
#if NORM_FOLD && STATS_FUSED && defined(DENSE_DOWN_F8)
        constexpr bool SKIP8 = (l == 0);
#else
        constexpr bool SKIP8 = false;
#endif
        if (SKIP8) ++ph; else {
        PHASE_BEGIN(8)
#ifdef DENSE_F8
            if (l == 0) phase_rmsnorm_f8(F, X, args.in[I_FFN_NORM] + (size_t)l * D, (unsigned char*)H);
#else
            if (l == 0) {
#if NORM_FOLD && defined(DENSE_DOWN_F8)
                phase_rowstats(F, X, (float*)(ws + WS_RSTD));
#else
                phase_rmsnorm_bf16(F, X, args.in[I_FFN_NORM] + (size_t)l * D, H);
#endif
            }
#endif
            else phase_rmsnorm_router(F, X, args.in[I_FFN_NORM] + (size_t)l * D, args.in[I_ROUTER], H, ws);
        PHASE_END
        }
        if (l == 0) {
            PHASE_BEGIN(9)
#ifdef DENSE_F8
                pg8::Gemm g{D / 2, D / 2, D / 2}; pg8::PlainSched<WGM_GU> S{M / 256, 2 * FF / 256, F.G, F.bx, (const char*)H, (const char*)(ws + WS_WGU), (size_t)256 * D, (size_t)256 * D};
                pg8::EpiSwiGluF8 E{ws + AR_HIDE, nullptr, 1.0f / WSCALE8};
                pg8::gemm_phase<true>(F.lds, F.tid, g, S, E);
#else
                pg8::Gemm g{D, D, D}; pg8::PlainSched<WGM_GU> S{M / 256, 2 * FF / 256, F.G, F.bx, (const char*)H, (const char*)(ws + WS_WGU), (size_t)256 * D * 2, (size_t)256 * D * 2};
#if defined(DENSE_DOWN_F8) && NORM_FOLD && STATS_FUSED
                S.A = (const char*)X;
                { const int mu = (S.nM * S.nN + F.G - 1) / F.G; pg8::fill_lrs(S, (const float*)(ws + WS_PART), F.lds, F.tid, mu < 23 ? mu : 23); }
                pg8::EpiSwiGluF8RL E{ws + AR_HIDE, (LAS const float*)(F.lds + pg8::LDS_LRS_OFF)};
#elif defined(DENSE_DOWN_F8) && NORM_FOLD
                S.A = (const char*)X;
                pg8::EpiSwiGluF8R E{ws + AR_HIDE, (const float*)(ws + WS_RSTD)};
#elif defined(DENSE_DOWN_F8)
                pg8::EpiSwiGluF8 E{ws + AR_HIDE, nullptr, 1.0f};
#else
                pg8::EpiSwiGlu E{(bf16_t*)(ws + AR_HIDE), nullptr};
#endif
                pg8::gemm_phase<false>(F.lds, F.tid, g, S, E);
#endif
            PHASE_END
#ifdef DUP9
            { Ctx F = F0; asm volatile("" : "+v"(F.tid)); F.lane = F.tid & 63; F.wave = __builtin_amdgcn_readfirstlane(F.tid >> 6);
                pg8::Gemm g{D, D, D}; pg8::PlainSched<WGM_GU> S{M / 256, 2 * FF / 256, F.G, F.bx, (const char*)H, (const char*)(ws + WS_WGU), (size_t)256 * D * 2, (size_t)256 * D * 2};
                pg8::EpiSwiGlu E{(bf16_t*)(ws + AR_HIDE), nullptr};
                pg8::gemm_phase<false>(F.lds, F.tid, g, S, E);
                xcd_barrier(bar); }
#endif
            PHASE_BEGIN(10)
#if defined(DENSE_F8) || defined(DENSE_DOWN_F8)
                pg8::Gemm g{FF / 2, FF / 2, FF / 2}; pg8::PlainSched<WGM_DOWN> S{M / 256, D / 256, F.G, F.bx, (const char*)(ws + AR_HIDE), (const char*)(ws + WS_WDN), (size_t)256 * FF, (size_t)256 * FF};
#if NORM_FOLD && STATS_FUSED
                pg8::EpiResB16S E{X, X, 1.0f / WSCALE8, (float*)(ws + WS_PART), (LAS float*)(F.lds + pg8::LDS_SS_OFF)};
#else
                pg8::EpiResB16<bf16_t> E{X, X, 1.0f / WSCALE8};
#endif
                pg8::gemm_phase<true>(F.lds, F.tid, g, S, E);
#else
                pg8::Gemm g{FF, FF, FF}; pg8::PlainSched<WGM_DOWN> S{M / 256, D / 256, F.G, F.bx, (const char*)(ws + AR_HIDE), (const char*)(ws + WS_WDN), (size_t)256 * FF * 2, (size_t)256 * FF * 2};
                pg8::EpiResB16<bf16_t> E{X, X, 1.0f};
                pg8::gemm_phase<false>(F.lds, F.tid, g, S, E);
#endif
            PHASE_END
        } else {
            PHASE_BEGIN(11)
                phase_moe_gather(F, args);
            PHASE_END
            PHASE_BEGIN(12)
                MoeSched<WGM_MOEGU, true> S; { const int* tpg = (const int*)(ws + WS_TP);
#pragma unroll
                    for (int e = 0; e < 9; ++e) S.tp[e] = __builtin_amdgcn_readfirstlane(tpg[e]); }
                S.nN = 2 * FF / 256; S.G = F.G; S.c = F.bx; S.A = (const char*)(ws + WS_H); S.B = (const char*)(ws + WS_WEGU); S.tA = (size_t)256 * D; S.tB = (size_t)256 * D; S.eB = SZ_WGU8; S.rowtok = (const int*)(ws + WS_ROWTOK);
                pg8::Gemm g{D / 2, D / 2, D / 2}; pg8::EpiSwiGluF8 E{ws + AR_HIDE, (const float*)(ws + WS_ROWGATE), 1.0f / WSCALE8};
                pg8::gemm_phase<true>(F.lds, F.tid, g, S, E);
            PHASE_END
            PHASE_BEGIN(13)
                MoeSched<WGM_MOEDN, false> S; { const int* tpg = (const int*)(ws + WS_TP);
#pragma unroll
                    for (int e = 0; e < 9; ++e) S.tp[e] = __builtin_amdgcn_readfirstlane(tpg[e]); }
                S.nN = D / 256; S.G = F.G; S.c = F.bx; S.A = (const char*)(ws + AR_HIDE); S.B = (const char*)(ws + WS_WEDN); S.tA = (size_t)256 * FF; S.tB = (size_t)256 * FF; S.eB = SZ_WDN8; S.rowtok = nullptr;
                pg8::Gemm g{FF / 2, FF / 2, FF / 2}; pg8::EpiMoeDown E{(const int*)(ws + WS_ROWTOK), X, (bf16_t*)(ws + AR_Y0), 1.0f / WSCALE8};
                pg8::gemm_phase<true>(F.lds, F.tid, g, S, E);
            PHASE_END
        }
    }
__global__ void __launch_bounds__(512, 2) hybrid_fwd(Args args_in) {
    extern __shared__ __attribute__((aligned(16))) unsigned char lds_raw[];
    KArgs* ka = (KArgs*)__builtin_amdgcn_kernarg_segment_ptr();
    Ctx F0; F0.lds = (LAS unsigned char*)lds_raw; F0.tid = threadIdx.x; F0.lane = F0.tid & 63; F0.wave = __builtin_amdgcn_readfirstlane(F0.tid >> 6);
    F0.G = gridDim.x; F0.bx = blockIdx.x; F0.vcu = (F0.G % 8 == 0) ? (F0.bx % 8) * (F0.G / 8) + F0.bx / 8 : F0.bx;
    volatile LAS unsigned* MISC = (volatile LAS unsigned*)(F0.lds + LDS_MISC);
    if (F0.tid < 64) MISC[F0.tid] = 0u;
    __syncthreads();
    XcdBarrier bar = xcd_barrier_post((unsigned*)(ka->ws + WS_CTL) + 1024, MISC + 8);
    const int lo = ka->ph_lo, hi = ka->ph_hi;
    int ph = 0;
    PHASE_BEGIN(0)
        p0_convert(F, args);
        __syncthreads(); RELAUNDER();
#if NORM_FOLD
        phase_x_bf16_stats(F, args.in[I_X], X, (float*)(ws + WS_RSTD));
#else
        phase_rmsnorm_bf16(F, args.in[I_X], args.in[I_ATTN_NORM], H);
#endif
    PHASE_END

    layer_phases<0>(F0, ka, bar, lo, hi, ph);
    layer_phases<1>(F0, ka, bar, lo, hi, ph);
    PHASE_BEGIN(14)
        phase_final_norm(F, X, (const bf16_t*)(ws + AR_Y0), args.in[I_FINAL_NORM], args.out);
    PHASE_END
#undef PHASE_BEGIN
#undef PHASE_END
#undef X
#undef H
#undef PROJ
#undef MIXED
}
constexpr int N_PHASES = 1 + 8 + 2 + 8 + 3 + 1;

#ifndef MK_PER_PHASE
#define MK_PER_PHASE 0
#endif
extern "C" void kernel_launch(void* const* d_in, const int* in_sizes, int n_in, void* d_out, int out_size, void* d_ws, size_t ws_size, hipStream_t stream) {
    static int grid = 0;
    if (grid == 0) {
        if (n_in != 24 || out_size != M * D || ws_size < WS_END) { fprintf(stderr, "kernel_launch: unexpected shapes (n_in %d out %d ws %zu need %zu)\n", n_in, out_size, ws_size, (size_t)WS_END); grid = -1; return; }
        int dev = 0, cus = 0, per_cu = 0;
        if (hipGetDevice(&dev) != hipSuccess || hipDeviceGetAttribute(&cus, hipDeviceAttributeMultiprocessorCount, dev) != hipSuccess) { grid = -1; return; }
        if (hipFuncSetAttribute((const void*)hybrid_fwd, hipFuncAttributeMaxDynamicSharedMemorySize, LDS_BYTES) != hipSuccess) { fprintf(stderr, "kernel_launch: hipFuncSetAttribute failed\n"); grid = -1; return; }
        if (hipOccupancyMaxActiveBlocksPerMultiprocessor(&per_cu, (const void*)hybrid_fwd, 512, LDS_BYTES) != hipSuccess || per_cu < 1) fprintf(stderr, "kernel_launch: occupancy query says %d\n", per_cu);
        (void)hipGetLastError();
        grid = cus < 256 ? cus : 256;
        if (grid != 256) fprintf(stderr, "kernel_launch: %d CUs; this kernel is written for 256\n", cus);
    }
    if (grid < 0) return;
    (void)hipMemsetAsync((char*)d_ws + WS_CTL, 0, CTL_ZERO_BYTES, stream);
    Args a{};
    for (int i = 0; i < 24; ++i) a.in[i] = (const float*)d_in[i];
    a.out = (float*)d_out; a.ws = (unsigned char*)d_ws;
#if MK_PER_PHASE
    for (int p = 0; p < N_PHASES; ++p) { a.ph_lo = p; a.ph_hi = p + 1; hipLaunchKernelGGL(hybrid_fwd, dim3(grid), dim3(512), LDS_BYTES, stream, a); }
#else
    a.ph_lo = 0; a.ph_hi = N_PHASES;
    hipLaunchKernelGGL(hybrid_fwd, dim3(grid), dim3(512), LDS_BYTES, stream, a);
#endif
}
```
